# Optimizing an MI355X kernel written in HIP

```python
import jax, jax.numpy as jnp
from jax import lax
import numpy as np

D_MODEL = 1024
BATCH = 1
SEQ = 16384
DEPTH = 1

N_HEADS_A = 16
N_KV_A = 2
HEAD_DIM_A = 64
GROUP_A = N_HEADS_A // N_KV_A
CMP_BLOCK = 32
CMP_STRIDE = 16
CMP_HIDDEN = 128
SEL_BLOCK = 64
SEL_TOPK = 16
WINDOW = 512
Q_BLOCK = 128
N_HEADS_R = 4
KEY_DIM_R = 128
VAL_DIM_R = 256
RET_CHUNK = 128
D_FF = ((8 * D_MODEL + 767) // 768) * 256
ROPE_THETA = 10000.0
EPS = 1e-6
NEG = -1e30
BIG = 1e9

W_Q_A = N_HEADS_A * HEAD_DIM_A
W_KV_A = 3 * 2 * N_KV_A * HEAD_DIM_A
W_G_A = 3 * N_HEADS_A
W_Q_R = N_HEADS_R * KEY_DIM_R
W_K_R = N_HEADS_R * KEY_DIM_R
W_V_R = N_HEADS_R * VAL_DIM_R
W_G_R = N_HEADS_R * VAL_DIM_R
W_MERGE = 2 * D_MODEL
IN_WIDTHS = (W_Q_A, W_KV_A, W_G_A, W_Q_R, W_K_R, W_V_R, W_G_R, W_MERGE)
IN_SPLITS = tuple(int(v) for v in np.cumsum(IN_WIDTHS)[:-1])
N_IN = sum(IN_WIDTHS)

kernel_name = "nsa_retention_gated_hybrid_block"


def _rmsnorm(x, g):
    xf = x.astype(jnp.float32)
    y = xf * lax.rsqrt(jnp.mean(xf * xf, axis=-1, keepdims=True) + EPS) * g.astype(jnp.float32)
    return y.astype(x.dtype)


def _rope(x, pos):
    d = x.shape[-1]
    half = d // 2
    inv = ROPE_THETA ** (-jnp.arange(half, dtype=jnp.float32) * 2.0 / d)
    ang = pos[:, None] * inv[None, :]
    cos = jnp.cos(ang)[None, :, None, :]
    sin = jnp.sin(ang)[None, :, None, :]
    xf = x.astype(jnp.float32)
    x1, x2 = xf[..., :half], xf[..., half:]
    return jnp.concatenate([x1 * cos - x2 * sin, x2 * cos + x1 * sin], axis=-1).astype(x.dtype)


def _masked_softmax(s, mask):
    s = jnp.where(mask, s, NEG)
    m = jnp.max(s, axis=-1, keepdims=True)
    p = jnp.exp(s - m) * mask
    return p / jnp.maximum(jnp.sum(p, axis=-1, keepdims=True), 1e-30)


def _compress(x, blk, pos_emb, w1, w2):
    B, _, hkv, _ = x.shape
    xb = x[:, blk] + pos_emb[None, None, :, None, :].astype(x.dtype)
    xb = xb.transpose(0, 1, 3, 2, 4).reshape(B, blk.shape[0], hkv, -1)
    return jax.nn.gelu(xb @ w1) @ w2


def _nsa(q, kc, vc, ks, vs, kw, vw, gates, cmp_pos_k, cmp_w1_k, cmp_w2_k, cmp_pos_v, cmp_w1_v, cmp_w2_v):
    B, S, H, Dh = q.shape
    n_cmp = (S - CMP_BLOCK) // CMP_STRIDE + 1
    n_sel = S // SEL_BLOCK
    n_top = min(SEL_TOPK, n_sel)
    scale = Dh ** -0.5
    blk = jnp.arange(n_cmp)[:, None] * CMP_STRIDE + jnp.arange(CMP_BLOCK)[None, :]
    k_cmp = _compress(kc, blk, cmp_pos_k, cmp_w1_k, cmp_w2_k)
    v_cmp = _compress(vc, blk, cmp_pos_v, cmp_w1_v, cmp_w2_v)
    cmp_end = jnp.arange(n_cmp) * CMP_STRIDE + CMP_BLOCK - 1
    cs = jnp.arange(n_cmp)[:, None] * CMP_STRIDE
    ss = jnp.arange(n_sel)[None, :] * SEL_BLOCK
    overlap = jnp.clip(jnp.minimum(cs + CMP_BLOCK, ss + SEL_BLOCK) - jnp.maximum(cs, ss), 0, None)
    cmp_to_sel = overlap.astype(jnp.float32) / CMP_BLOCK
    k_sel_blk = ks.reshape(B, n_sel, SEL_BLOCK, N_KV_A, Dh).transpose(0, 3, 1, 2, 4)
    v_sel_blk = vs.reshape(B, n_sel, SEL_BLOCK, N_KV_A, Dh).transpose(0, 3, 1, 2, 4)
    pad = ((0, 0), (WINDOW, 0), (0, 0), (0, 0))
    k_win = jnp.pad(kw, pad)
    v_win = jnp.pad(vw, pad)
    b_idx = jnp.arange(B)[:, None, None, None]
    h_idx = jnp.arange(N_KV_A)[None, None, :, None]
    sel_off = jnp.arange(SEL_BLOCK)
    win_off = jnp.arange(WINDOW + Q_BLOCK) - WINDOW
    jb = jnp.arange(n_sel)[None, :]

    def block(i):
        s0 = i * Q_BLOCK
        t = s0 + jnp.arange(Q_BLOCK)
        qb = lax.dynamic_slice_in_dim(q, s0, Q_BLOCK, axis=1).reshape(B, Q_BLOCK, N_KV_A, GROUP_A, Dh)
        gb = lax.dynamic_slice_in_dim(gates, s0, Q_BLOCK, axis=1).reshape(B, Q_BLOCK, N_KV_A, GROUP_A, 3)
        s = jnp.einsum('bqkgd,bnkd->bqkgn', qb, k_cmp).astype(jnp.float32) * scale
        cmask = (cmp_end[None, :] <= t[:, None])[None, :, None, None, :]
        p_cmp = _masked_softmax(s, cmask)
        o_cmp = jnp.einsum('bqkgn,bnkd->bqkgd', p_cmp.astype(v_cmp.dtype), v_cmp)
        imp = jnp.einsum('bqkgn,nj->bqkj', p_cmp, cmp_to_sel)
        cur = (t // SEL_BLOCK)[:, None]
        causal = (jb <= cur)[None, :, None, :]
        forced = ((jb == 0) | (jb == cur) | (jb == cur - 1))[None, :, None, :]
        score = jnp.where(forced, BIG, jnp.where(causal, imp, NEG))
        top_val, top_idx = lax.top_k(score, n_top)
        top_ok = top_val > 0.5 * NEG
        kg = k_sel_blk[b_idx, h_idx, top_idx].reshape(B, Q_BLOCK, N_KV_A, n_top * SEL_BLOCK, Dh)
        vg = v_sel_blk[b_idx, h_idx, top_idx].reshape(B, Q_BLOCK, N_KV_A, n_top * SEL_BLOCK, Dh)
        kpos = top_idx[..., None] * SEL_BLOCK + sel_off
        smask = (top_ok[..., None] & (kpos <= t[None, :, None, None, None]))
        smask = smask.reshape(B, Q_BLOCK, N_KV_A, 1, n_top * SEL_BLOCK)
        s = jnp.einsum('bqkgd,bqkmd->bqkgm', qb, kg).astype(jnp.float32) * scale
        p_sel = _masked_softmax(s, smask)
        o_sel = jnp.einsum('bqkgm,bqkmd->bqkgd', p_sel.astype(vg.dtype), vg)
        kwb = lax.dynamic_slice_in_dim(k_win, s0, WINDOW + Q_BLOCK, axis=1)
        vwb = lax.dynamic_slice_in_dim(v_win, s0, WINDOW + Q_BLOCK, axis=1)
        kp = (s0 + win_off)[None, :]
        wmask = (kp <= t[:, None]) & (kp > t[:, None] - WINDOW) & (kp >= 0)
        s = jnp.einsum('bqkgd,bmkd->bqkgm', qb, kwb).astype(jnp.float32) * scale
        p_win = _masked_softmax(s, wmask[None, :, None, None, :])
        o_win = jnp.einsum('bqkgm,bmkd->bqkgd', p_win.astype(vwb.dtype), vwb)
        o = gb[..., 0:1] * o_cmp + gb[..., 1:2] * o_sel + gb[..., 2:3] * o_win
        return o.reshape(B, Q_BLOCK, H * Dh)

    out = lax.map(block, jnp.arange(S // Q_BLOCK))
    return out.transpose(1, 0, 2, 3).reshape(B, S, H * Dh)


def _retention(q, k, v):
    B, S, Hr, Dk = q.shape
    Dv = v.shape[-1]
    C = RET_CHUNK
    nc = S // C
    log_g = jnp.log1p(-jnp.exp2(-5.0 - jnp.arange(Hr, dtype=jnp.float32)))
    i = jnp.arange(C, dtype=jnp.float32)
    diff = i[:, None] - i[None, :]
    decay_in = jnp.where(diff >= 0, jnp.exp(log_g[:, None, None] * jnp.maximum(diff, 0.0)), 0.0)
    decay_q = jnp.exp(log_g[:, None] * (i + 1.0))[..., None]
    decay_k = jnp.exp(log_g[:, None] * (C - 1.0 - i))[..., None]
    decay_c = jnp.exp(log_g * C)[:, None, None]

    def to_chunks(a):
        return a.reshape(B, nc, C, Hr, a.shape[-1]).transpose(1, 0, 3, 2, 4).astype(jnp.float32)

    def step(R, inp):
        qi, ki, vi = inp
        inner = jnp.einsum('bhid,bhjd->bhij', qi, ki) * decay_in
        o = jnp.einsum('bhij,bhje->bhie', inner, vi) + jnp.einsum('bhid,bhde->bhie', qi, R) * decay_q
        R = R * decay_c + jnp.einsum('bhjd,bhje->bhde', ki * decay_k, vi)
        return R, o

    R0 = jnp.zeros((B, Hr, Dk, Dv), jnp.float32)
    _, o = lax.scan(step, R0, (to_chunks(q), to_chunks(k), to_chunks(v)))
    return o.transpose(1, 0, 3, 2, 4).reshape(B, S, Hr, Dv)


def setup_inputs(seed: int = 0) -> dict:
    key = jax.random.key(seed)
    ks = jax.random.split(key, 20)
    f32 = jnp.float32
    L = DEPTH
    nrm = lambda k, shape, s: jax.random.normal(k, shape, f32) * s
    gain = lambda k: 1.0 + 0.1 * jax.random.normal(k, (L, D_MODEL), f32)
    cmp_in = CMP_BLOCK * HEAD_DIM_A
    return {
        "x": jax.random.normal(ks[0], (BATCH, SEQ, D_MODEL), f32),
        "g_pre_mix": gain(ks[1]),
        "w_in": nrm(ks[2], (L, D_MODEL, N_IN), D_MODEL ** -0.5),
        "cmp_pos_k": nrm(ks[3], (L, CMP_BLOCK, HEAD_DIM_A), 0.1),
        "cmp_w1_k": nrm(ks[4], (L, cmp_in, CMP_HIDDEN), cmp_in ** -0.5),
        "cmp_w2_k": nrm(ks[5], (L, CMP_HIDDEN, HEAD_DIM_A), CMP_HIDDEN ** -0.5),
        "cmp_pos_v": nrm(ks[6], (L, CMP_BLOCK, HEAD_DIM_A), 0.1),
        "cmp_w1_v": nrm(ks[7], (L, cmp_in, CMP_HIDDEN), cmp_in ** -0.5),
        "cmp_w2_v": nrm(ks[8], (L, CMP_HIDDEN, HEAD_DIM_A), CMP_HIDDEN ** -0.5),
        "w_branch_a": nrm(ks[9], (L, N_HEADS_A * HEAD_DIM_A, D_MODEL), (N_HEADS_A * HEAD_DIM_A) ** -0.5),
        "w_branch_b": nrm(ks[10], (L, N_HEADS_R * VAL_DIM_R, D_MODEL), (N_HEADS_R * VAL_DIM_R) ** -0.5),
        "w_out": nrm(ks[11], (L, D_MODEL, D_MODEL), D_MODEL ** -0.5),
        "g_post_mix": gain(ks[12]),
        "g_pre_ffn": gain(ks[13]),
        "w_ffn_gate": nrm(ks[14], (L, D_MODEL, D_FF), D_MODEL ** -0.5),
        "w_ffn_up": nrm(ks[15], (L, D_MODEL, D_FF), D_MODEL ** -0.5),
        "w_ffn_down": nrm(ks[16], (L, D_FF, D_MODEL), D_FF ** -0.5),
        "g_post_ffn": gain(ks[17]),
    }


def reference(x, g_pre_mix, w_in, cmp_pos_k, cmp_w1_k, cmp_w2_k, cmp_pos_v, cmp_w1_v, cmp_w2_v,
              w_branch_a, w_branch_b, w_out, g_post_mix, g_pre_ffn, w_ffn_gate, w_ffn_up,
              w_ffn_down, g_post_ffn):
    B, S, _ = x.shape
    pos = jnp.arange(S, dtype=jnp.float32)
    for l in range(DEPTH):
        h = _rmsnorm(x, g_pre_mix[l])
        z = h @ w_in[l]
        q_a, kv_a, ga_logit, q_r, k_r, v_r, g_r, m_logit = jnp.split(z, IN_SPLITS, axis=-1)
        q_a = _rope(q_a.reshape(B, S, N_HEADS_A, HEAD_DIM_A), pos)
        kv_a = kv_a.reshape(B, S, 6, N_KV_A, HEAD_DIM_A)
        kc = _rope(kv_a[:, :, 0], pos)
        vc = kv_a[:, :, 1]
        ksl = _rope(kv_a[:, :, 2], pos)
        vsl = kv_a[:, :, 3]
        kw = _rope(kv_a[:, :, 4], pos)
        vw = kv_a[:, :, 5]
        gates_a = jax.nn.sigmoid(ga_logit).reshape(B, S, N_HEADS_A, 3)
        y_a = _nsa(q_a, kc, vc, ksl, vsl, kw, vw, gates_a,
                   cmp_pos_k[l], cmp_w1_k[l], cmp_w2_k[l], cmp_pos_v[l], cmp_w1_v[l], cmp_w2_v[l])
        q_r = _rope(q_r.reshape(B, S, N_HEADS_R, KEY_DIM_R), pos) * (KEY_DIM_R ** -0.5)
        k_r = _rope(k_r.reshape(B, S, N_HEADS_R, KEY_DIM_R), pos)
        ret = _retention(q_r, k_r, v_r.reshape(B, S, N_HEADS_R, VAL_DIM_R))
        ret = (ret - jnp.mean(ret, -1, keepdims=True)) * lax.rsqrt(jnp.var(ret, -1, keepdims=True) + EPS)
        y_r = (jax.nn.silu(g_r.astype(jnp.float32)) * ret.reshape(B, S, -1)).astype(x.dtype)
        m_a, m_b = jnp.split(jax.nn.sigmoid(m_logit), 2, axis=-1)
        mix = (m_a * (y_a @ w_branch_a[l]) + m_b * (y_r @ w_branch_b[l])) @ w_out[l]
        x = x + _rmsnorm(mix, g_post_mix[l])
        h = _rmsnorm(x, g_pre_ffn[l])
        f = (jax.nn.silu(h @ w_ffn_gate[l]) * (h @ w_ffn_up[l])) @ w_ffn_down[l]
        x = x + _rmsnorm(f, g_post_ffn[l])
    return x
```

```cpp
#include <hip/hip_runtime.h>
#include <hip/hip_bf16.h>
#include <hip/hip_cooperative_groups.h>
#include <cstdio>
namespace cg = cooperative_groups;

#ifndef ONE_LAUNCH
#define ONE_LAUNCH 1
#endif

typedef unsigned short u16;
using bf16x8 = __attribute__((ext_vector_type(8))) short;
using f32x4 = __attribute__((ext_vector_type(4))) float;
using u32x4 = __attribute__((ext_vector_type(4))) unsigned;
using u32x2 = __attribute__((ext_vector_type(2))) unsigned;
using f16x8 = __attribute__((ext_vector_type(8))) _Float16;

#define S_ 16384
#define NEGF (-1e30f)
#define BIGF (1e9f)

struct Params {
  const float *x, *g_pre_mix, *w_in, *cpk, *cw1k, *cw2k, *cpv, *cw1v, *cw2v, *wba, *wbb, *wout, *g_post_mix, *g_pre_ffn, *wg, *wu, *wd, *g_post_ffn;
  float* out;
  char* ws;
};

constexpr size_t MB = (size_t)1 << 20;
constexpr size_t OFF_HH = 0, OFF_HL = 32 * MB, OFF_RTB = 32 * MB, OFF_QHI = 64 * MB, OFF_QLO = 96 * MB, OFF_YR = 96 * MB,
                 OFF_QR = 128 * MB, OFF_KR = 144 * MB, OFF_KRTD = 160 * MB, OFF_VRT = 176 * MB, OFF_KS = 208 * MB, OFF_KW = 212 * MB,
                 OFF_VST = 216 * MB, OFF_VWT = 220 * MB, OFF_PBUF = 208 * MB, OFF_GATES = 224 * MB, OFF_KCH = 227 * MB,
                 OFF_KCL = 227 * MB + 256 * 1024, OFF_VCT = 227 * MB + 512 * 1024, OFF_WBA = 228 * MB, OFF_WBB = 230 * MB,
                 OFF_WOUT = 232 * MB, OFF_WGU = 234 * MB, OFF_WD = 245 * MB, OFF_W1LO = 250 * MB + 512 * 1024,
                 OFF_SSQ1 = 253 * MB, OFF_SSQ2 = 253 * MB + 512 * 1024, OFF_CTR = 254 * MB, OFF_BAR = 254 * MB + 4096,
                 OFF_MERGEDF = 128 * MB, OFF_MERGED = 32 * MB, OFF_MIX = 128 * MB, OFF_H2 = 0, OFF_ACT = 32 * MB, OFF_F = 128 * MB;
constexpr size_t OO_W1T = 0, OO_CS64 = 14 * MB, OO_CS128 = 18 * MB, OO_UT = 14 * MB, OO_KC = 46 * MB, OO_VC = 54 * MB, OO_GB = 46 * MB;
constexpr size_t OFF_G = 32 * MB;
constexpr size_t OFF_GA = 160 * MB;

__device__ __forceinline__ int otid() { int t = threadIdx.x; asm volatile("" : "+v"(t)); return t; }
__device__ __forceinline__ int obid() { int b = blockIdx.x; asm volatile("" : "+s"(b)); return b; }
__device__ __forceinline__ u16 f2bf(float f) {
  unsigned u = __float_as_uint(f);
  u += 0x7fffu + ((u >> 16) & 1u);
  return (u16)(u >> 16);
}
__device__ __forceinline__ u16 f2h(float f) { union { _Float16 h; u16 u; } t; t.h = (_Float16)f; return t.u; }
__device__ __forceinline__ unsigned packh2(float a, float b) { return (unsigned)f2h(a) | ((unsigned)f2h(b) << 16); }
__device__ __forceinline__ f32x4 mfma16(bf16x8 a, bf16x8 b, f32x4 c) {
  union { bf16x8 s; f16x8 h; } ta, tb; ta.s = a; tb.s = b;
  return __builtin_amdgcn_mfma_f32_16x16x32_f16(ta.h, tb.h, c, 0, 0, 0);
}
__device__ __forceinline__ float bf2f(u16 h) { return __uint_as_float(((unsigned)h) << 16); }
__device__ __forceinline__ unsigned pack2(float a, float b) { return (unsigned)f2bf(a) | ((unsigned)f2bf(b) << 16); }
__device__ __forceinline__ float sigmoidf_(float x) { return 1.f / (1.f + __expf(-x)); }
__device__ __forceinline__ float siluf_(float x) { return x / (1.f + __expf(-x)); }

__device__ __forceinline__ float logg_of(int hd) {
  return hd == 0 ? -0.0317486972f : (hd == 1 ? -0.0157483574f : (hd == 2 ? -0.00784317777f : -0.00391389942f));
}

#define BK 64
#define LDT 72
#define SMEM_BYTES 73744

__device__ __forceinline__ void zero_acc(f32x4 (&acc)[2][8]) {
#pragma unroll
  for (int a = 0; a < 2; a++)
#pragma unroll
    for (int b = 0; b < 8; b++) acc[a][b] = f32x4{0.f, 0.f, 0.f, 0.f};
}

#define GBUF (2 * 128 * LDT)
__device__ __forceinline__ void gemm_store(const u32x4 (&ra)[4], const u32x4 (&rb)[4], u16* sA, int lrow, int lc) {
#pragma unroll
  for (int i = 0; i < 4; i++) {
    *(u32x4*)(sA + (lrow + i * 32) * LDT + lc) = ra[i];
    *(u32x4*)(sA + 128 * LDT + (lrow + i * 32) * LDT + lc) = rb[i];
  }
}
__device__ __forceinline__ void gemm_load(u32x4 (&ra)[4], u32x4 (&rb)[4], const u16* pa, const u16* pb, int lda, int ldb) {
#pragma unroll
  for (int i = 0; i < 4; i++) {
    ra[i] = *(const u32x4*)(pa + (size_t)(i * 32) * lda);
    rb[i] = *(const u32x4*)(pb + (size_t)(i * 32) * ldb);
  }
}
template <bool F16>
__device__ __forceinline__ void gemm_compute(f32x4 (&acc)[2][8], const u16* sA, int wave, int quad, int r16) {
  const u16* sB = sA + 128 * LDT;
  __builtin_amdgcn_s_setprio(2);
#pragma unroll
  for (int ks = 0; ks < 2; ks++) {
    bf16x8 af[2];
#pragma unroll
    for (int mt = 0; mt < 2; mt++) af[mt] = *(const bf16x8*)(sA + (wave * 32 + mt * 16 + r16) * LDT + ks * 32 + quad * 8);
#pragma unroll
    for (int nh = 0; nh < 2; nh++) {
      bf16x8 bfr[4];
#pragma unroll
      for (int nt = 0; nt < 4; nt++) bfr[nt] = *(const bf16x8*)(sB + ((nh * 4 + nt) * 16 + r16) * LDT + ks * 32 + quad * 8);
#pragma unroll
      for (int mt = 0; mt < 2; mt++)
#pragma unroll
        for (int nt = 0; nt < 4; nt++)
          acc[mt][nh * 4 + nt] = F16 ? mfma16(af[mt], bfr[nt], acc[mt][nh * 4 + nt])
                                     : __builtin_amdgcn_mfma_f32_16x16x32_bf16(af[mt], bfr[nt], acc[mt][nh * 4 + nt], 0, 0, 0);
    }
  }
  __builtin_amdgcn_s_setprio(0);
}

template <bool F16 = false>
__device__ __forceinline__ void gemm_acc(f32x4 (&acc)[2][8], const u16* A, int lda, const u16* B, int ldb, int K, u16* sA, u16*  ) {
  const int tid = otid(), lane = tid & 63, wave = tid >> 6, quad = lane >> 4, r16 = lane & 15;
  const int lrow = tid >> 3, lc = (tid & 7) * 8;
  const u16* pa = A + (size_t)lrow * lda + lc;
  const u16* pb = B + (size_t)lrow * ldb + lc;
  u16* s0 = sA;
  u16* s1 = sA + GBUF;
  u32x4 ra0[4], rb0[4], ra1[4], rb1[4];
  const int nk = K / BK;
  gemm_load(ra0, rb0, pa, pb, lda, ldb);
  gemm_load(ra1, rb1, pa + BK, pb + BK, lda, ldb);
  __syncthreads();
  gemm_store(ra0, rb0, s0, lrow, lc);
  if (nk > 2) gemm_load(ra0, rb0, pa + 2 * BK, pb + 2 * BK, lda, ldb);
  __syncthreads();
  for (int kt = 0; kt < nk; kt += 2) {
    gemm_compute<F16>(acc, s0, wave, quad, r16);
    __builtin_amdgcn_sched_barrier(0);
    gemm_store(ra1, rb1, s1, lrow, lc);
    if (kt + 3 < nk) gemm_load(ra1, rb1, pa + (kt + 3) * BK, pb + (kt + 3) * BK, lda, ldb);
    __syncthreads();
    gemm_compute<F16>(acc, s1, wave, quad, r16);
    __builtin_amdgcn_sched_barrier(0);
    if (kt + 2 < nk) {
      gemm_store(ra0, rb0, s0, lrow, lc);
      if (kt + 4 < nk) gemm_load(ra0, rb0, pa + (kt + 4) * BK, pb + (kt + 4) * BK, lda, ldb);
    }
    __syncthreads();
  }
}

__device__ __forceinline__ void gemm_acc_wide(f32x4 (&acc)[2][16], const u16* A, int lda, const u16* B, int ldb, int K, u16* sA) {
  const int tid = otid(), lane = tid & 63, wave = tid >> 6, quad = lane >> 4, r16 = lane & 15;
  const int lrow = tid >> 3, lc = (tid & 7) * 8;
  const u16* pa = A + (size_t)lrow * lda + lc;
  const u16* pb = B + (size_t)lrow * ldb + lc;
  u16* sB = sA + 128 * LDT;
  u32x4 ra[4], rb[8];
#pragma unroll
  for (int i = 0; i < 4; i++) ra[i] = *(const u32x4*)(pa + (size_t)(i * 32) * lda);
#pragma unroll
  for (int i = 0; i < 8; i++) rb[i] = *(const u32x4*)(pb + (size_t)(i * 32) * ldb);
  const int nk = K / BK;
  for (int kt = 0; kt < nk; kt++) {
    __syncthreads();
#pragma unroll
    for (int i = 0; i < 4; i++) *(u32x4*)(sA + (lrow + i * 32) * LDT + lc) = ra[i];
#pragma unroll
    for (int i = 0; i < 8; i++) *(u32x4*)(sB + (lrow + i * 32) * LDT + lc) = rb[i];
    __syncthreads();
    if (kt + 1 < nk) {
      pa += BK; pb += BK;
#pragma unroll
      for (int i = 0; i < 4; i++) ra[i] = *(const u32x4*)(pa + (size_t)(i * 32) * lda);
#pragma unroll
      for (int i = 0; i < 8; i++) rb[i] = *(const u32x4*)(pb + (size_t)(i * 32) * ldb);
    }
    __builtin_amdgcn_s_setprio(2);
#pragma unroll
    for (int ks = 0; ks < 2; ks++) {
      bf16x8 af[2];
#pragma unroll
      for (int mt = 0; mt < 2; mt++) af[mt] = *(const bf16x8*)(sA + (wave * 32 + mt * 16 + r16) * LDT + ks * 32 + quad * 8);
#pragma unroll
      for (int nq = 0; nq < 4; nq++) {
        bf16x8 bfr[4];
#pragma unroll
        for (int nt = 0; nt < 4; nt++) bfr[nt] = *(const bf16x8*)(sB + ((nq * 4 + nt) * 16 + r16) * LDT + ks * 32 + quad * 8);
#pragma unroll
        for (int mt = 0; mt < 2; mt++)
#pragma unroll
          for (int nt = 0; nt < 4; nt++)
            acc[mt][nq * 4 + nt] = __builtin_amdgcn_mfma_f32_16x16x32_bf16(af[mt], bfr[nt], acc[mt][nq * 4 + nt], 0, 0, 0);
      }
    }
    __builtin_amdgcn_s_setprio(0);
  }
  __syncthreads();
}

__device__ const float ROPE_INV[96] = {1.0f, 0.749894202f, 0.562341332f, 0.421696514f, 0.316227764f, 0.237137377f, 0.177827939f, 0.133352146f, 0.100000001f, 0.0749894232f, 0.0562341325f, 0.0421696492f, 0.0316227749f, 0.0237137377f, 0.0177827943f, 0.013335214f, 0.00999999978f, 0.00749894232f, 0.00562341325f, 0.00421696482f, 0.00316227763f, 0.00237137382f, 0.00177827943f, 0.00133352145f, 0.00100000005f, 0.000749894185f, 0.000562341302f, 0.000421696517f, 0.000316227757f, 0.00023713737f, 0.00017782794f, 0.00013335215f, 1.0f, 0.865964353f, 0.749894202f, 0.649381638f, 0.562341332f, 0.486967534f, 0.421696514f, 0.365174115f, 0.316227764f, 0.273841977f, 0.237137377f, 0.2053525f, 0.177827939f, 0.153992653f, 0.133352146f, 0.115478195f, 0.100000001f, 0.0865964293f, 0.0749894232f, 0.0649381652f, 0.0562341325f, 0.0486967526f, 0.0421696492f, 0.0365174115f, 0.0316227749f, 0.0273841955f, 0.0237137377f, 0.0205352511f, 0.0177827943f, 0.0153992651f, 0.013335214f, 0.0115478197f, 0.00999999978f, 0.00865964312f, 0.00749894232f, 0.00649381615f, 0.00562341325f, 0.00486967526f, 0.00421696482f, 0.00365174119f, 0.00316227763f, 0.00273841969f, 0.00237137382f, 0.00205352507f, 0.00177827943f, 0.00153992651f, 0.00133352145f, 0.00115478202f, 0.00100000005f, 0.000865964335f, 0.000749894185f, 0.000649381604f, 0.000562341302f, 0.000486967532f, 0.000421696517f, 0.000365174114f, 0.000316227757f, 0.000273841957f, 0.00023713737f, 0.00020535251f, 0.00017782794f, 0.00015399266f, 0.00013335215f, 0.0001154782f};

__device__ __forceinline__ bool next_tile(int it, int Mt, int Nt, int SM, int SN, int& mt, int& nt, bool& valid) {
  const int G = gridDim.x, bid = obid();
  if (G == 512) {
    const int xcd = bid & 7, l = bid >> 3;
    const int nsm = (Mt + SM - 1) / SM, nsn = (Nt + SN - 1) / SN;
    const int sb = it * 8 + xcd;
    if (sb >= nsm * nsn) return false;
    const int sm = sb % nsm, sn = sb / nsm;
    mt = sm * SM + l / SN; nt = sn * SN + l % SN;
    valid = (mt < Mt) && (nt < Nt);
    return true;
  } else {
    const int task = bid + it * G;
    if (task >= Mt * Nt) return false;
    mt = task / Nt; nt = task % Nt; valid = true;
    return true;
  }
}

__device__ __forceinline__ void tconv_tile(const float* src, int ld_src, int k0, int n_src0, int nvalid, u16* dst_hi, u16* dst_lo, int ld_dst,
                                           int n_dst0, float* tile) {
  const int tid = otid();
  __syncthreads();
#pragma unroll
  for (int i = 0; i < 16; i++) {
    int r = i * 4 + (tid >> 6), c = tid & 63;
    float v = (c < nvalid) ? src[(size_t)(k0 + r) * ld_src + n_src0 + c] : 0.f;
    tile[r * 65 + c] = v;
  }
  __syncthreads();
  const int n = tid >> 2, kc = (tid & 3) * 16;
  unsigned hi[8], lo[8];
#pragma unroll
  for (int e = 0; e < 8; e++) {
    float a = tile[(kc + 2 * e) * 65 + n], b = tile[(kc + 2 * e + 1) * 65 + n];
    u16 ah = f2bf(a), bh = f2bf(b);
    hi[e] = (unsigned)ah | ((unsigned)bh << 16);
    lo[e] = packh2(a, b);
  }
  u16* d = dst_hi + (size_t)(n_dst0 + n) * ld_dst + k0 + kc;
  *(uint4*)d = uint4{hi[0], hi[1], hi[2], hi[3]};
  *(uint4*)(d + 8) = uint4{hi[4], hi[5], hi[6], hi[7]};
  if (dst_lo) {
    u16* dl = dst_lo + (size_t)(n_dst0 + n) * ld_dst + k0 + kc;
    *(uint4*)dl = uint4{lo[0], lo[1], lo[2], lo[3]};
    *(uint4*)(dl + 8) = uint4{lo[4], lo[5], lo[6], lo[7]};
  }
}

__device__ __forceinline__ void wconv_tasks(const Params& p, char* smem, int lo, int hi) {
  char* ws = p.ws;
  char* oo = (char*)p.out;
  float* tile = (float*)smem;
  for (int task = lo + obid(); task < hi; task += gridDim.x) {
    if (task < 1760) {
      int a = task >> 4, kt = task & 15;
      int nd = a * 64, ns, nv = 64;
      if (nd < 1792) ns = nd;
      else if (nd == 1792) { ns = 1792; nv = 48; }
      else if (nd == 1856) { ns = 0; nv = 0; }
      else ns = nd - 80;
      tconv_tile(p.w_in, 6960, kt * 64, ns, nv, (u16*)(oo + OO_W1T), (nd < 1152) ? (u16*)(ws + OFF_W1LO) : nullptr, 1024, nd, tile);
    } else if (task < 1760 + 768) {
      int t = task - 1760, wsel = t >> 8, r = t & 255, a = r >> 4, kt = r & 15;
      const float* src = wsel == 0 ? p.wba : (wsel == 1 ? p.wbb : p.wout);
      u16* dst = (u16*)(ws + (wsel == 0 ? OFF_WBA : (wsel == 1 ? OFF_WBB : OFF_WOUT)));
      tconv_tile(src, 1024, kt * 64, a * 64, 64, dst, nullptr, 1024, a * 64, tile);
    } else if (task < 1760 + 768 + 1408) {
      int t = task - 2528, a = t >> 4, kt = t & 15;
      const float* src = (a & 1) ? p.wu : p.wg;
      tconv_tile(src, 2816, kt * 64, (a >> 1) * 64, 64, (u16*)(ws + OFF_WGU), nullptr, 1024, a * 64, tile);
    } else {
      int t = task - 3936, a = t / 44, kt = t % 44;
      tconv_tile(p.wd, 1024, kt * 64, a * 64, 64, (u16*)(ws + OFF_WD), nullptr, 2816, a * 64, tile);
    }
  }
  __syncthreads();
}

__device__ __forceinline__ void phase0(const Params& p, char* smem) {
  char* ws = p.ws;
  char* oo = (char*)p.out;
  float* tile = (float*)smem;
  const int tid = otid(), lane = tid & 63, wave = tid >> 6;
  if (obid() == 0 && tid < 4) ((unsigned*)(ws + OFF_CTR))[tid] = 0u;
  wconv_tasks(p, smem, 0, 1760);
  const int gw = obid() * 4 + wave, nw = gridDim.x * 4;
  u16* hh = (u16*)(ws + OFF_HH);
  u16* hl = (u16*)(ws + OFF_HL);
  for (int row0 = gw * 4; row0 < S_; row0 += nw * 4) {
    f32x4 v[4][4], g[4];
    float ss[4];
#pragma unroll
    for (int r = 0; r < 4; r++)
#pragma unroll
      for (int i = 0; i < 4; i++) v[r][i] = ((const f32x4*)(p.x + (size_t)(row0 + r) * 1024))[lane + 64 * i];
#pragma unroll
    for (int i = 0; i < 4; i++) g[i] = ((const f32x4*)p.g_pre_mix)[lane + 64 * i];
#pragma unroll
    for (int r = 0; r < 4; r++) {
      ss[r] = 0.f;
#pragma unroll
      for (int i = 0; i < 4; i++) ss[r] += v[r][i][0] * v[r][i][0] + v[r][i][1] * v[r][i][1] + v[r][i][2] * v[r][i][2] + v[r][i][3] * v[r][i][3];
    }
#pragma unroll
    for (int o = 32; o >= 1; o >>= 1)
#pragma unroll
      for (int r = 0; r < 4; r++) ss[r] += __shfl_xor(ss[r], o);
#pragma unroll
    for (int r = 0; r < 4; r++) {
      const float rs = rsqrtf(ss[r] * (1.f / 1024.f) + 1e-6f);
#pragma unroll
      for (int i = 0; i < 4; i++) {
        const f32x4 y = v[r][i] * rs * g[i];
        u32x2 H, L;
        H.x = pack2(y[0], y[1]); H.y = pack2(y[2], y[3]);
        L.x = packh2(y[0], y[1]); L.y = packh2(y[2], y[3]);
        *(u32x2*)(hh + (size_t)(row0 + r) * 1024 + (lane + 64 * i) * 4) = H;
        *(u32x2*)(hl + (size_t)(row0 + r) * 1024 + (lane + 64 * i) * 4) = L;
      }
    }
  }
  float2* cs64 = (float2*)(oo + OO_CS64);
  float2* cs128 = (float2*)(oo + OO_CS128);
  const int gt = obid() * 256 + tid, nt = gridDim.x * 256;
  for (int e = gt; e < S_ * 96; e += nt) {
    int t = e / 96, i = e % 96;
    float ang = (float)t * ROPE_INV[i];
    float sn, cn;
    sincosf(ang, &sn, &cn);
    if (i < 32) cs64[t * 32 + i] = float2{cn, sn};
    else cs128[t * 64 + (i - 32)] = float2{cn, sn};
  }
}

__device__ __forceinline__ void p1_epilogue(const Params& p, int nti, int m0, f32x4 (&acc)[2][8]) {
  char* ws = p.ws;
  char* oo = (char*)p.out;
  const int tid = otid(), lane = tid & 63, wave = tid >> 6, quad = lane >> 4, r16 = lane & 15;
  const int rbase = m0 + wave * 32 + quad * 4;
  const bool rope64 = (nti <= 8) || nti == 10 || nti == 12;
  const bool rope128 = (nti >= 15 && nti <= 22);
  if (rope64) {
    const float2* cs64 = (const float2*)(oo + OO_CS64);
#pragma unroll
    for (int mt = 0; mt < 2; mt++)
#pragma unroll
      for (int i = 0; i < 4; i++) {
        int tok = rbase + mt * 16 + i;
#pragma unroll
        for (int j = 0; j < 2; j++) {
          float2 cs = cs64[tok * 32 + j * 16 + r16];
#pragma unroll
          for (int hh = 0; hh < 2; hh++) {
            float x1 = acc[mt][hh * 4 + j][i], x2 = acc[mt][hh * 4 + j + 2][i];
            acc[mt][hh * 4 + j][i] = x1 * cs.x - x2 * cs.y;
            acc[mt][hh * 4 + j + 2][i] = x2 * cs.x + x1 * cs.y;
          }
        }
      }
  } else if (rope128) {
    const float2* cs128 = (const float2*)(oo + OO_CS128);
    const float sc = (nti <= 18) ? 0.08838834764831845f : 1.f;
#pragma unroll
    for (int mt = 0; mt < 2; mt++)
#pragma unroll
      for (int i = 0; i < 4; i++) {
        int tok = rbase + mt * 16 + i;
#pragma unroll
        for (int j = 0; j < 4; j++) {
          float2 cs = cs128[tok * 64 + j * 16 + r16];
          float x1 = acc[mt][j][i], x2 = acc[mt][j + 4][i];
          acc[mt][j][i] = (x1 * cs.x - x2 * cs.y) * sc;
          acc[mt][j + 4][i] = (x2 * cs.x + x1 * cs.y) * sc;
        }
      }
  }
  if (nti < 8) {
    u16* qh = (u16*)(ws + OFF_QHI);
    u16* ql = (u16*)(ws + OFF_QLO);
#pragma unroll
    for (int mt = 0; mt < 2; mt++)
#pragma unroll
      for (int nt = 0; nt < 8; nt++)
#pragma unroll
        for (int i = 0; i < 4; i++) {
          int tok = rbase + mt * 16 + i, col = nti * 128 + nt * 16 + r16;
          float v = acc[mt][nt][i];
          qh[(size_t)tok * 1024 + col] = f2bf(v);
          ql[(size_t)tok * 1024 + col] = f2h(v);
        }
  } else if (nti == 8 || nti == 9) {
    float* dst = (float*)(oo + (nti == 8 ? OO_KC : OO_VC));
#pragma unroll
    for (int mt = 0; mt < 2; mt++)
#pragma unroll
      for (int nt = 0; nt < 8; nt++)
#pragma unroll
        for (int i = 0; i < 4; i++) dst[(size_t)(rbase + mt * 16 + i) * 128 + nt * 16 + r16] = acc[mt][nt][i];
  } else if (nti == 10) {
    u16* dst = (u16*)(ws + OFF_KS);
#pragma unroll
    for (int mt = 0; mt < 2; mt++)
#pragma unroll
      for (int nt = 0; nt < 8; nt++)
#pragma unroll
        for (int i = 0; i < 4; i++) {
          const int tok = rbase + mt * 16 + i, col = nt * 16 + r16;
          const int kvh = col >> 6, d = col & 63;
          const size_t idx = (((((size_t)kvh * 256 + (tok >> 6)) * 4 + ((tok >> 4) & 3)) * 2 + (d >> 5)) * 64 + ((d >> 3) & 3) * 16 + (tok & 15)) * 8 + (d & 7);
          dst[idx] = f2bf(acc[mt][nt][i]);
        }
  } else if (nti == 12) {
    u16* dst = (u16*)(ws + OFF_KW);
#pragma unroll
    for (int mt = 0; mt < 2; mt++)
#pragma unroll
      for (int nt = 0; nt < 8; nt++)
#pragma unroll
        for (int i = 0; i < 4; i++) dst[(size_t)(rbase + mt * 16 + i) * 128 + nt * 16 + r16] = f2bf(acc[mt][nt][i]);
  } else if (nti == 11) {
    u16* dst = (u16*)(ws + OFF_VST);
#pragma unroll
    for (int mt = 0; mt < 2; mt++)
#pragma unroll
      for (int nt = 0; nt < 8; nt++) {
        const int tok = rbase + mt * 16, col = nt * 16 + r16;
        const int kvh = col >> 6, d = col & 63, kap = tok & 63;
        const int kk = kap >> 5, half = (kap >> 4) & 1, q = (kap >> 2) & 3;
        const size_t idx = (((((size_t)kvh * 256 + (tok >> 6)) * 2 + kk) * 4 + (d >> 4)) * 64 + q * 16 + (d & 15)) * 8 + 4 * half;
        uint2 v;
        v.x = pack2(acc[mt][nt][0], acc[mt][nt][1]);
        v.y = pack2(acc[mt][nt][2], acc[mt][nt][3]);
        *(uint2*)(dst + idx) = v;
      }
  } else if (nti == 13) {
    u16* dst = (u16*)(ws + OFF_VWT);
#pragma unroll
    for (int mt = 0; mt < 2; mt++)
#pragma unroll
      for (int nt = 0; nt < 8; nt++) {
        uint2 v;
        v.x = pack2(acc[mt][nt][0], acc[mt][nt][1]);
        v.y = pack2(acc[mt][nt][2], acc[mt][nt][3]);
        *(uint2*)(dst + (size_t)(nt * 16 + r16) * S_ + rbase + mt * 16) = v;
      }
  } else if (nti == 14) {
    float* dst = (float*)(ws + OFF_GATES);
#pragma unroll
    for (int mt = 0; mt < 2; mt++)
#pragma unroll
      for (int nt = 0; nt < 3; nt++)
#pragma unroll
        for (int i = 0; i < 4; i++) dst[(size_t)(rbase + mt * 16 + i) * 48 + nt * 16 + r16] = sigmoidf_(acc[mt][nt][i]);
  } else if (nti <= 18) {
    u16* dst = (u16*)(ws + OFF_QR);
    const int hd = nti - 15;
#pragma unroll
    for (int mt = 0; mt < 2; mt++)
#pragma unroll
      for (int nt = 0; nt < 8; nt++)
#pragma unroll
        for (int i = 0; i < 4; i++) dst[(size_t)(rbase + mt * 16 + i) * 512 + hd * 128 + nt * 16 + r16] = f2bf(acc[mt][nt][i]);
  } else if (nti <= 22) {
    u16* dst = (u16*)(ws + OFF_KR);
    u16* dstT = (u16*)(ws + OFF_KRTD);
    const int hd = nti - 19;
    const float logg = logg_of(hd);
#pragma unroll
    for (int mt = 0; mt < 2; mt++) {
      float dk[4];
#pragma unroll
      for (int i = 0; i < 4; i++) dk[i] = __expf(logg * (float)(127 - ((rbase + mt * 16 + i) & 127)));
#pragma unroll
      for (int nt = 0; nt < 8; nt++) {
#pragma unroll
        for (int i = 0; i < 4; i++) dst[(size_t)(rbase + mt * 16 + i) * 512 + hd * 128 + nt * 16 + r16] = f2bf(acc[mt][nt][i]);
        uint2 v;
        v.x = pack2(acc[mt][nt][0] * dk[0], acc[mt][nt][1] * dk[1]);
        v.y = pack2(acc[mt][nt][2] * dk[2], acc[mt][nt][3] * dk[3]);
        *(uint2*)(dstT + (size_t)(hd * 128 + nt * 16 + r16) * S_ + rbase + mt * 16) = v;
      }
    }
  } else {
    u16* dstT = (u16*)(ws + OFF_VRT);
    const int cb = (nti - 23) * 128;
#pragma unroll
    for (int mt = 0; mt < 2; mt++)
#pragma unroll
      for (int nt = 0; nt < 8; nt++) {
        uint2 v;
        v.x = pack2(acc[mt][nt][0], acc[mt][nt][1]);
        v.y = pack2(acc[mt][nt][2], acc[mt][nt][3]);
        *(uint2*)(dstT + (size_t)(cb + nt * 16 + r16) * S_ + rbase + mt * 16) = v;
      }
  }
}

__device__ __forceinline__ void phase1(const Params& p, char* smem) {
  u16* sA = (u16*)smem;
  u16* sB = sA + 128 * LDT;
  const u16* hh = (const u16*)(p.ws + OFF_HH);
  const u16* hl = (const u16*)(p.ws + OFF_HL);
  const u16* w1 = (const u16*)((char*)p.out + OO_W1T);
  const u16* w1lo = (const u16*)(p.ws + OFF_W1LO);
  for (int it = 0;; it++) {
    int mtile, nti; bool valid;
    if (!next_tile(it, 128, 31, 8, 8, mtile, nti, valid)) break;
    if (!valid) continue;
    const int m0 = mtile * 128, n0 = nti * 128;
    f32x4 acc[2][8];
    zero_acc(acc);
    if (nti < 9) gemm_acc<true>(acc, hl + (size_t)m0 * 1024, 1024, w1lo + (size_t)n0 * 1024, 1024, 1024, sA, sB);
    else gemm_acc(acc, hh + (size_t)m0 * 1024, 1024, w1 + (size_t)n0 * 1024, 1024, 1024, sA, sB);
    p1_epilogue(p, nti, m0, acc);
  }
}

__device__ __forceinline__ void phase2(const Params& p, char* smem) {
  float* tile = (float*)smem;
  float* posl = tile + 144 * 64;
  float* red = tile;
  float* hid = posl + 32 * 64;
  const int tid = otid();
  char* oo = (char*)p.out;
  for (int task = obid(); task < 512; task += gridDim.x) {
    const int which = task >> 8, head = (task >> 7) & 1, g = task & 127;
    const float* src = (const float*)(oo + (which ? OO_VC : OO_KC));
    const float* pos = which ? p.cpv : p.cpk;
    const float* w1 = which ? p.cw1v : p.cw1k;
    const float* w2 = which ? p.cw2v : p.cw2k;
    __syncthreads();
#pragma unroll
    for (int i = 0; i < 9; i++) {
      int id = tid + 256 * i, tk = id >> 4, c4 = id & 15, tok = 128 * g + tk;
      float4 v = float4{0.f, 0.f, 0.f, 0.f};
      if (tok < S_) v = *(const float4*)(src + (size_t)tok * 128 + head * 64 + c4 * 4);
      ((float4*)tile)[tk * 16 + c4] = v;
    }
#pragma unroll
    for (int i = 0; i < 2; i++) ((float4*)posl)[tid + 256 * i] = ((const float4*)pos)[tid + 256 * i];
    __syncthreads();
    const int j4 = tid & 31, kp = tid >> 5;
    float acc[9][4];
#pragma unroll
    for (int r = 0; r < 9; r++)
#pragma unroll
      for (int cc = 0; cc < 4; cc++) acc[r][cc] = 0.f;
    for (int l = kp * 4; l < kp * 4 + 4; l++) {
#pragma unroll 2
      for (int d4 = 0; d4 < 16; d4++) {
        const int kk = l * 64 + d4 * 4;
        float4 wv[4];
#pragma unroll
        for (int q = 0; q < 4; q++) wv[q] = *(const float4*)(w1 + (size_t)(kk + q) * 128 + j4 * 4);
#pragma unroll
        for (int r = 0; r < 9; r++) {
          const float4 xv = (r < 8) ? ((const float4*)tile)[(16 * r + l) * 16 + d4] : ((const float4*)posl)[l * 16 + d4];
          acc[r][0] += xv.x * wv[0].x + xv.y * wv[1].x + xv.z * wv[2].x + xv.w * wv[3].x;
          acc[r][1] += xv.x * wv[0].y + xv.y * wv[1].y + xv.z * wv[2].y + xv.w * wv[3].y;
          acc[r][2] += xv.x * wv[0].z + xv.y * wv[1].z + xv.z * wv[2].z + xv.w * wv[3].z;
          acc[r][3] += xv.x * wv[0].w + xv.y * wv[1].w + xv.z * wv[2].w + xv.w * wv[3].w;
        }
      }
    }
    __syncthreads();
#pragma unroll
    for (int r = 0; r < 9; r++) *(float4*)(red + (kp * 9 + r) * 128 + j4 * 4) = float4{acc[r][0], acc[r][1], acc[r][2], acc[r][3]};
    __syncthreads();
#pragma unroll
    for (int i = 0; i < 4; i++) {
      int id = tid + 256 * i, r = id >> 7, jj = id & 127;
      float xh = 0.f;
#pragma unroll
      for (int k = 0; k < 8; k++) xh += red[(k * 9 + r) * 128 + jj] + red[(k * 9 + 8) * 128 + jj];
      float u = 0.7978845608028654f * (xh + 0.044715f * xh * xh * xh);
      hid[r * 128 + jj] = 0.5f * xh * (2.f - 2.f / (1.f + __expf(2.f * u)));
    }
    __syncthreads();
    {
      const int r = tid >> 5, d = (tid & 31) * 2;
      float o0 = 0.f, o1 = 0.f;
      for (int jj = 0; jj < 128; jj++) {
        float hv = hid[r * 128 + jj];
        float2 wv = *(const float2*)(w2 + jj * 64 + d);
        o0 += hv * wv.x; o1 += hv * wv.y;
      }
      const int n = g * 8 + r;
      if (n == 1023) { o0 = 0.f; o1 = 0.f; }
      if (which == 0) {
        u16* kh_ = (u16*)(p.ws + OFF_KCH);
        u16* kl_ = (u16*)(p.ws + OFF_KCL);
        *(unsigned*)(kh_ + n * 128 + head * 64 + d) = packh2(o0, o1);
        (void)kl_;
      } else {
        u16* vt = (u16*)(p.ws + OFF_VCT);
        vt[(head * 64 + d) * 1024 + n] = f2bf(o0);
        vt[(head * 64 + d + 1) * 1024 + n] = f2bf(o1);
      }
    }
  }
}

__device__ __forceinline__ void phase2_ut(const Params& p, char* smem) {
  char* ws = p.ws;
  u16* sA = (u16*)smem;
  u16* sB = sA + 128 * LDT;
  const int tid = otid(), lane = tid & 63, wave = tid >> 6, quad = lane >> 4, r16 = lane & 15;
  u16* ut = (u16*)((char*)p.out + OO_UT);
  for (int task = obid(); task < 1024; task += gridDim.x) {
    const int cch = task >> 3, hd = (task >> 1) & 3, dvt = task & 1;
    const u16* vrt = (const u16*)(ws + OFF_VRT) + (size_t)(hd * 256 + dvt * 128) * S_ + cch * 128;
    const u16* krt = (const u16*)(ws + OFF_KRTD) + (size_t)(hd * 128) * S_ + cch * 128;
    f32x4 acc[2][8];
    zero_acc(acc);
    gemm_acc(acc, vrt, S_, krt, S_, 128, sA, sB);
    u16* dst = ut + ((size_t)(cch * 4 + hd) * 256 + dvt * 128) * 128;
#pragma unroll
    for (int mt = 0; mt < 2; mt++)
#pragma unroll
      for (int nt = 0; nt < 8; nt++)
#pragma unroll
        for (int i = 0; i < 4; i++) dst[(wave * 32 + mt * 16 + quad * 4 + i) * 128 + nt * 16 + r16] = f2bf(acc[mt][nt][i]);
  }
}

#define P3_KH 0
#define P3_KL 9216
#define P3_V 18432
#define P3_IMP 27648
#define P3_SEL (27648 + 4 * NG * 2 * 1040)
#define P3_SELN (P3_SEL + 4 * NG * 2 * 64)
#define P3_TASK (P3_SELN + 128)
#define P3T 72
#define NG 2

template <int CTRL>
__device__ __forceinline__ float dpp_f(float a) { return __int_as_float(__builtin_amdgcn_mov_dpp(__float_as_int(a), CTRL, 0xf, 0xf, true)); }
__device__ __forceinline__ float hsum8(float a) {
  a += dpp_f<0xB1>(a);
  a += dpp_f<0x4E>(a);
  a += dpp_f<0x141>(a);
  return a;
}

__device__ __forceinline__ void softmax_pv(f32x4 (&s)[4], int kbase, bool colactive, int tq, int W, const bf16x8 (&vf)[2][4], f32x4 (&o)[4],
                                           float& m_run, float& l_run, int quad) {
  float mx = NEGF;
  bool ok[4][4];
#pragma unroll
  for (int a = 0; a < 4; a++)
#pragma unroll
    for (int i = 0; i < 4; i++) {
      int kpos = kbase + 16 * a + 4 * quad + i;
      ok[a][i] = colactive && (kpos <= tq) && (kpos > tq - W);
      s[a][i] *= 0.125f;
      if (ok[a][i]) mx = fmaxf(mx, s[a][i]);
    }
  mx = fmaxf(mx, __shfl_xor(mx, 16));
  mx = fmaxf(mx, __shfl_xor(mx, 32));
  const float m_new = fmaxf(m_run, mx);
  const float alpha = __expf(m_run - m_new);
  m_run = m_new;
  float ps = 0.f;
#pragma unroll
  for (int a = 0; a < 4; a++)
#pragma unroll
    for (int i = 0; i < 4; i++) {
      float pv = ok[a][i] ? __expf(s[a][i] - m_new) : 0.f;
      s[a][i] = pv;
      ps += pv;
    }
  l_run = l_run * alpha + ps;
#pragma unroll
  for (int dt = 0; dt < 4; dt++)
#pragma unroll
    for (int i = 0; i < 4; i++) o[dt][i] *= alpha;
#pragma unroll
  for (int kk = 0; kk < 2; kk++) {
    union { bf16x8 v; unsigned u[4]; } pf;
    pf.u[0] = pack2(s[2 * kk][0], s[2 * kk][1]);
    pf.u[1] = pack2(s[2 * kk][2], s[2 * kk][3]);
    pf.u[2] = pack2(s[2 * kk + 1][0], s[2 * kk + 1][1]);
    pf.u[3] = pack2(s[2 * kk + 1][2], s[2 * kk + 1][3]);
#pragma unroll
    for (int dt = 0; dt < 4; dt++) o[dt] = __builtin_amdgcn_mfma_f32_16x16x32_bf16(vf[kk][dt], pf.v, o[dt], 0, 0, 0);
  }
}

__device__ __forceinline__ void attn_tile_task(const Params& p, int qt, int kvh, char* smem) {
  char* ws = p.ws;
  const int tid = otid(), lane = tid & 63, wave = tid >> 6, quad = lane >> 4, c = lane & 15, qsel = c >> 3, h = c & 7;
  const int t0 = qt * (8 * NG), tw = t0 + wave * (2 * NG), H = kvh * 8 + h;
  u16* sKh = (u16*)(smem + P3_KH);
  u16* sKl = (u16*)(smem + P3_KL);
  u16* sV = (u16*)(smem + P3_V);
  volatile float* imp = (volatile float*)(smem + P3_IMP + wave * (NG * 2 * 1040));
  volatile int* sel = (volatile int*)(smem + P3_SEL + wave * (NG * 2 * 64));
  volatile int* seln = (volatile int*)(smem + P3_SELN + wave * 32);
  const u16* q_hi = (const u16*)(ws + OFF_QHI);
  const u16* q_lo = (const u16*)(ws + OFF_QLO);
  u16* part = (u16*)(ws + OFF_QLO);
  const float* gates = (const float*)(ws + OFF_GATES);
  const int lr = tid >> 3, lcc = (tid & 7) * 8;

#ifndef CMPREP
#define CMPREP 1
#endif
#pragma unroll 1
  for (int rep = 0; rep < CMPREP; rep++) {
    bf16x8 ql[NG][2];
    int nmaxq[NG];
#pragma unroll
    for (int g = 0; g < NG; g++) {
      const int tq = tw + 2 * g + qsel;
      nmaxq[g] = (tq - 31) >> 4;
#pragma unroll
      for (int ks = 0; ks < 2; ks++) {
        ql[g][ks] = *(const bf16x8*)(q_lo + (size_t)tq * 1024 + H * 64 + ks * 32 + quad * 8);
      }
    }
    const int nmaxt = (t0 + 8 * NG - 32) >> 4;
    const int NCH = nmaxt >= 0 ? (nmaxt >> 6) + 1 : 0;
    const u16* kch = (const u16*)(ws + OFF_KCH) + kvh * 64;
    const u16* kcl = (const u16*)(ws + OFF_KCL) + kvh * 64;
    const u16* vct = (const u16*)(ws + OFF_VCT) + (size_t)(kvh * 64) * 1024;
    float m_l[NG], l_l[NG];
#pragma unroll
    for (int g = 0; g < NG; g++) { m_l[g] = NEGF; l_l[g] = 0.f; }
    u32x4 pk[4], pv[2];
#pragma unroll
    for (int i = 0; i < 2; i++) {
      pk[i] = *(const u32x4*)(kch + (size_t)(lr + 32 * i) * 128 + lcc);
    }
    for (int ch = 0; ch < NCH; ch++) {
      __syncthreads();
#pragma unroll
      for (int i = 0; i < 2; i++) {
        *(u32x4*)(sKh + (lr + 32 * i) * P3T + lcc) = pk[i];
      }
      __syncthreads();
      if (ch + 1 < NCH) {
#pragma unroll
        for (int i = 0; i < 2; i++) {
          pk[i] = *(const u32x4*)(kch + (size_t)(64 * (ch + 1) + lr + 32 * i) * 128 + lcc);
        }
      }
#pragma unroll
      for (int a = 0; a < 4; a++) {
        bf16x8 kh_[2];
#pragma unroll
        for (int ks = 0; ks < 2; ks++) {
          kh_[ks] = *(const bf16x8*)(sKh + (16 * a + c) * P3T + ks * 32 + quad * 8);
        }
        const int nb = 64 * ch + 16 * a + 4 * quad;
#pragma unroll
        for (int g = 0; g < NG; g++) {
          f32x4 s = f32x4{0.f, 0.f, 0.f, 0.f};
#pragma unroll
          for (int ks = 0; ks < 2; ks++) {
            s = mfma16(kh_[ks], ql[g][ks], s);
          }
          float mx = NEGF;
#pragma unroll
          for (int i = 0; i < 4; i++) {
            s[i] *= 0.125f;
            if (nb + i <= nmaxq[g]) mx = fmaxf(mx, s[i]);
          }
          const float m_new = fmaxf(m_l[g], mx);
          float ll = l_l[g] * __expf(m_l[g] - m_new);
#pragma unroll
          for (int i = 0; i < 4; i++)
            if (nb + i <= nmaxq[g]) ll += __expf(s[i] - m_new);
          l_l[g] = ll;
          m_l[g] = m_new;
        }
      }
    }
    float Mx[NG], invL[NG];
#pragma unroll
    for (int g = 0; g < NG; g++) {
      float M = fmaxf(m_l[g], __shfl_xor(m_l[g], 16));
      M = fmaxf(M, __shfl_xor(M, 32));
      float ll = l_l[g] * __expf(m_l[g] - M);
      ll += __shfl_xor(ll, 16);
      ll += __shfl_xor(ll, 32);
      Mx[g] = M;
      invL[g] = (ll > 0.f) ? 1.f / ll : 0.f;
    }
    f32x4 ocmp[NG][4];
    float carry[NG];
#pragma unroll
    for (int g = 0; g < NG; g++) {
      carry[g] = 0.f;
#pragma unroll
      for (int dt = 0; dt < 4; dt++) ocmp[g][dt] = f32x4{0.f, 0.f, 0.f, 0.f};
    }
#pragma unroll
    for (int i = 0; i < 2; i++) {
      pk[i] = *(const u32x4*)(kch + (size_t)(lr + 32 * i) * 128 + lcc);
      pv[i] = *(const u32x4*)(vct + (size_t)(lr + 32 * i) * 1024 + lcc);
    }
    for (int ch = 0; ch < NCH; ch++) {
      __syncthreads();
#pragma unroll
      for (int i = 0; i < 2; i++) {
        *(u32x4*)(sKh + (lr + 32 * i) * P3T + lcc) = pk[i];
        *(u32x4*)(sV + (lr + 32 * i) * P3T + lcc) = pv[i];
      }
      __syncthreads();
      if (ch + 1 < NCH) {
#pragma unroll
        for (int i = 0; i < 2; i++) {
          pk[i] = *(const u32x4*)(kch + (size_t)(64 * (ch + 1) + lr + 32 * i) * 128 + lcc);
          pv[i] = *(const u32x4*)(vct + (size_t)(lr + 32 * i) * 1024 + 64 * (ch + 1) + lcc);
        }
      }
#pragma unroll
      for (int kk = 0; kk < 2; kk++) {
        float pr[NG][2][4];
#pragma unroll
        for (int e = 0; e < 2; e++) {
          const int a = 2 * kk + e;
          bf16x8 kh_[2];
#pragma unroll
          for (int ks = 0; ks < 2; ks++) {
            kh_[ks] = *(const bf16x8*)(sKh + (16 * a + c) * P3T + ks * 32 + quad * 8);
          }
          const int nb = 64 * ch + 16 * a + 4 * quad;
#pragma unroll
          for (int g = 0; g < NG; g++) {
            f32x4 s = f32x4{0.f, 0.f, 0.f, 0.f};
#pragma unroll
            for (int ks = 0; ks < 2; ks++) {
              s = mfma16(kh_[ks], ql[g][ks], s);
            }
#pragma unroll
            for (int i = 0; i < 4; i++) pr[g][e][i] = (nb + i <= nmaxq[g]) ? __expf(s[i] * 0.125f - Mx[g]) * invL[g] : 0.f;
            float av = hsum8(pr[g][e][0] + pr[g][e][1] + pr[g][e][2] + 0.5f * pr[g][e][3]);
            float bv = hsum8(0.5f * pr[g][e][3]);
            const float bs = __shfl(bv, (lane + 48) & 63);
            av += (quad > 0) ? bs : carry[g];
            carry[g] = bs;
            if (h == 0) imp[(2 * g + qsel) * 260 + 16 * ch + 4 * a + quad] = av;
          }
        }
        bf16x8 vf[4];
#pragma unroll
        for (int dt = 0; dt < 4; dt++) {
          union { bf16x8 v; u32x2 u[2]; } t;
          t.u[0] = *(const u32x2*)(sV + (dt * 16 + c) * P3T + 32 * kk + 4 * quad);
          t.u[1] = *(const u32x2*)(sV + (dt * 16 + c) * P3T + 32 * kk + 16 + 4 * quad);
          vf[dt] = t.v;
        }
#pragma unroll
        for (int g = 0; g < NG; g++) {
          union { bf16x8 v; unsigned u[4]; } pf;
          pf.u[0] = pack2(pr[g][0][0], pr[g][0][1]);
          pf.u[1] = pack2(pr[g][0][2], pr[g][0][3]);
          pf.u[2] = pack2(pr[g][1][0], pr[g][1][1]);
          pf.u[3] = pack2(pr[g][1][2], pr[g][1][3]);
#pragma unroll
          for (int dt = 0; dt < 4; dt++) ocmp[g][dt] = __builtin_amdgcn_mfma_f32_16x16x32_bf16(vf[dt], pf.v, ocmp[g][dt], 0, 0, 0);
        }
      }
    }
#pragma unroll
    for (int g = 0; g < NG; g++) {
      const int tq = tw + 2 * g + qsel;
      const float g0 = gates[(size_t)tq * 48 + H * 3 + 0];
#pragma unroll
      for (int dt = 0; dt < 4; dt++) {
        u32x2 v;
        v.x = pack2(g0 * ocmp[g][dt][0], g0 * ocmp[g][dt][1]);
        v.y = pack2(g0 * ocmp[g][dt][2], g0 * ocmp[g][dt][3]);
        *(u32x2*)(part + (size_t)tq * 1024 + H * 64 + dt * 16 + 4 * quad) = v;
      }
    }
  }

#ifndef WINREP
#define WINREP 1
#endif
#pragma unroll 1
  for (int wrep = 0; wrep < WINREP; wrep++) {
    bf16x8 qh[NG][2];
    int tqs[NG];
#pragma unroll
    for (int g = 0; g < NG; g++) {
      tqs[g] = tw + 2 * g + qsel;
#pragma unroll
      for (int ks = 0; ks < 2; ks++) qh[g][ks] = *(const bf16x8*)(q_hi + (size_t)tqs[g] * 1024 + H * 64 + ks * 32 + quad * 8);
    }
    f32x4 ow[NG][4];
    float mw[NG], lw[NG];
#pragma unroll
    for (int g = 0; g < NG; g++) {
      mw[g] = NEGF; lw[g] = 0.f;
#pragma unroll
      for (int dt = 0; dt < 4; dt++) ow[g][dt] = f32x4{0.f, 0.f, 0.f, 0.f};
    }
    const u16* kwb = (const u16*)(ws + OFF_KW) + kvh * 64;
    const u16* vwt = (const u16*)(ws + OFF_VWT) + (size_t)(kvh * 64) * S_;
    int lo = t0 - 511; if (lo < 0) lo = 0;
    const int jlo = lo >> 6, jhi = (t0 + 8 * NG - 1) >> 6;
    u32x4 pk[2], pv[2];
#pragma unroll
    for (int i = 0; i < 2; i++) {
      pk[i] = *(const u32x4*)(kwb + (size_t)(64 * jlo + lr + 32 * i) * 128 + lcc);
      pv[i] = *(const u32x4*)(vwt + (size_t)(lr + 32 * i) * S_ + 64 * jlo + lcc);
    }
    for (int j = jlo; j <= jhi; j++) {
      __syncthreads();
#pragma unroll
      for (int i = 0; i < 2; i++) {
        *(u32x4*)(sKh + (lr + 32 * i) * P3T + lcc) = pk[i];
        *(u32x4*)(sV + (lr + 32 * i) * P3T + lcc) = pv[i];
      }
      __syncthreads();
      if (j + 1 <= jhi) {
#pragma unroll
        for (int i = 0; i < 2; i++) {
          pk[i] = *(const u32x4*)(kwb + (size_t)(64 * (j + 1) + lr + 32 * i) * 128 + lcc);
          pv[i] = *(const u32x4*)(vwt + (size_t)(lr + 32 * i) * S_ + 64 * (j + 1) + lcc);
        }
      }
      bf16x8 kf[4][2], vf[2][4];
#pragma unroll
      for (int a = 0; a < 4; a++)
#pragma unroll
        for (int ks = 0; ks < 2; ks++) kf[a][ks] = *(const bf16x8*)(sKh + (16 * a + c) * P3T + ks * 32 + quad * 8);
#pragma unroll
      for (int kk = 0; kk < 2; kk++)
#pragma unroll
        for (int dt = 0; dt < 4; dt++) {
          union { bf16x8 v; u32x2 u[2]; } t;
          t.u[0] = *(const u32x2*)(sV + (dt * 16 + c) * P3T + 32 * kk + 4 * quad);
          t.u[1] = *(const u32x2*)(sV + (dt * 16 + c) * P3T + 32 * kk + 16 + 4 * quad);
          vf[kk][dt] = t.v;
        }
#pragma unroll
      for (int g = 0; g < NG; g++) {
        f32x4 s[4];
#pragma unroll
        for (int a = 0; a < 4; a++) {
          s[a] = f32x4{0.f, 0.f, 0.f, 0.f};
#pragma unroll
          for (int ks = 0; ks < 2; ks++) s[a] = __builtin_amdgcn_mfma_f32_16x16x32_bf16(kf[a][ks], qh[g][ks], s[a], 0, 0, 0);
        }
        softmax_pv(s, 64 * j, true, tqs[g], 512, vf, ow[g], mw[g], lw[g], quad);
      }
    }
#pragma unroll
    for (int g = 0; g < NG; g++) {
      float L = lw[g] + __shfl_xor(lw[g], 16);
      L += __shfl_xor(L, 32);
      const float g2 = gates[(size_t)tqs[g] * 48 + H * 3 + 2] / fmaxf(L, 1e-30f);
#pragma unroll
      for (int dt = 0; dt < 4; dt++) {
        u16* pp = part + (size_t)tqs[g] * 1024 + H * 64 + dt * 16 + 4 * quad;
        u32x2 v = *(const u32x2*)pp;
        float y0 = __uint_as_float(v.x << 16) + g2 * ow[g][dt][0];
        float y1 = __uint_as_float(v.x & 0xffff0000u) + g2 * ow[g][dt][1];
        float y2 = __uint_as_float(v.y << 16) + g2 * ow[g][dt][2];
        float y3 = __uint_as_float(v.y & 0xffff0000u) + g2 * ow[g][dt][3];
        v.x = pack2(y0, y1); v.y = pack2(y2, y3);
        if (wrep == WINREP - 1 || L == 12345.678f) *(u32x2*)pp = v;
      }
    }
  }

#ifndef TOPKREP
#define TOPKREP 1
#endif
#pragma unroll 1
  for (int trep = 0; trep < TOPKREP; trep++) {
    const unsigned long long lt = (1ull << lane) - 1ull;
    unsigned bitsq[2 * NG][4], thq[2 * NG];
    int Rq[2 * NG];
    bool srch[2 * NG], act[2 * NG];
#pragma unroll
    for (int qi = 0; qi < 2 * NG; qi++) {
      const int cur = (tw + qi) >> 6;
#pragma unroll
      for (int e = 0; e < 4; e++) {
        const int jj = lane + 64 * e;
        const bool forced = (jj == 0) || (jj == cur) || (jj == cur - 1);
        const bool cand = (jj <= cur) && !forced;
        const float iv = imp[qi * 260 + jj];
        bitsq[qi][e] = cand ? __float_as_uint(iv) : 0u;
      }
      const int F = (cur == 0) ? 1 : ((cur == 1) ? 2 : 3);
      Rq[qi] = 16 - F;
      srch[qi] = (cur + 1 - F) > Rq[qi];
      act[qi] = srch[qi];
      thq[qi] = 0u;
    }
    for (int bit = 30; bit >= 0; bit--) {
      bool any = false;
#pragma unroll
      for (int qi = 0; qi < 2 * NG; qi++) {
        if (act[qi]) {
          const unsigned t2 = thq[qi] | (1u << bit);
          int cnt = 0;
#pragma unroll
          for (int e = 0; e < 4; e++) cnt += __popcll(__ballot(bitsq[qi][e] >= t2));
          if (cnt >= Rq[qi]) {
            thq[qi] = t2;
            if (cnt == Rq[qi]) act[qi] = false;
          }
        }
        any = any || act[qi];
      }
      if (!any) break;
    }
#pragma unroll
    for (int qi = 0; qi < 2 * NG; qi++) {
      const int cur = (tw + qi) >> 6;
      bool forced[4], cand[4], selv[4];
#pragma unroll
      for (int e = 0; e < 4; e++) {
        const int jj = lane + 64 * e;
        forced[e] = (jj == 0) || (jj == cur) || (jj == cur - 1);
        cand[e] = (jj <= cur) && !forced[e];
      }
      if (!srch[qi]) {
#pragma unroll
        for (int e = 0; e < 4; e++) selv[e] = forced[e] || cand[e];
      } else {
        const unsigned th = thq[qi];
        int cgt = 0;
#pragma unroll
        for (int e = 0; e < 4; e++) cgt += __popcll(__ballot(cand[e] && bitsq[qi][e] > th));
        const int need = Rq[qi] - cgt;
        int prior = 0;
#pragma unroll
        for (int e = 0; e < 4; e++) {
          const bool eq = cand[e] && bitsq[qi][e] == th;
          const unsigned long long m = __ballot(eq);
          const int rank = prior + __popcll(m & lt);
          selv[e] = forced[e] || (cand[e] && bitsq[qi][e] > th) || (eq && rank < need);
          prior += __popcll(m);
        }
      }
      if (qi & 1) {
#pragma unroll
        for (int e = 0; e < 4; e++) selv[e] = selv[e] && !forced[e];
      }
      int base = 0;
#pragma unroll
      for (int e = 0; e < 4; e++) {
        const unsigned long long m = __ballot(selv[e]);
        if (selv[e]) sel[qi * 16 + base + __popcll(m & lt)] = lane + 64 * e;
        base += __popcll(m);
      }
      if (lane == 0) seln[qi] = base;
    }
  }
  __builtin_amdgcn_wave_barrier();

  {
    const u16* ksb = (const u16*)(ws + OFF_KS) + (size_t)kvh * 256 * 4096 + lane * 8;
    const u16* vst = (const u16*)(ws + OFF_VST) + (size_t)kvh * 256 * 4096 + lane * 8;
    u16* ya = (u16*)(ws + OFF_QHI);
    const int curb = tw >> 6;
    bf16x8 qh[NG][2];
    f32x4 os[NG][4];
    float ms[NG], ls[NG];
    int tqs[NG], n0[NG], ntot[NG];
    u32x4 kn[NG][4][2], vn[NG][2][4];
    int jn[NG];
    int nmax = 0;
#pragma unroll
    for (int g = 0; g < NG; g++) {
      tqs[g] = tw + 2 * g + qsel;
      ms[g] = NEGF; ls[g] = 0.f;
#pragma unroll
      for (int ks = 0; ks < 2; ks++) qh[g][ks] = *(const bf16x8*)(q_hi + (size_t)tqs[g] * 1024 + H * 64 + ks * 32 + quad * 8);
#pragma unroll
      for (int dt = 0; dt < 4; dt++) os[g][dt] = f32x4{0.f, 0.f, 0.f, 0.f};
      n0[g] = __builtin_amdgcn_readfirstlane(seln[2 * g]);
      ntot[g] = n0[g] + __builtin_amdgcn_readfirstlane(seln[2 * g + 1]);
      nmax = ntot[g] > nmax ? ntot[g] : nmax;
      jn[g] = __builtin_amdgcn_readfirstlane(sel[(2 * g) * 16]);
      const u16* kp = ksb + (size_t)jn[g] * 4096;
      const u16* vp = vst + (size_t)jn[g] * 4096;
#pragma unroll
      for (int a = 0; a < 4; a++)
#pragma unroll
        for (int ks = 0; ks < 2; ks++) kn[g][a][ks] = *(const u32x4*)(kp + (a * 2 + ks) * 512);
#pragma unroll
      for (int kk = 0; kk < 2; kk++)
#pragma unroll
        for (int dt = 0; dt < 4; dt++) vn[g][kk][dt] = *(const u32x4*)(vp + (kk * 4 + dt) * 512);
    }
    for (int idx = 0; idx < nmax; idx++) {
#pragma unroll
      for (int g = 0; g < NG; g++) {
        const int jthis = jn[g];
        const bool valid = idx < ntot[g];
        const int qs = (idx < n0[g]) ? 0 : 1;
        f32x4 sc[4];
        bf16x8 vf[2][4];
#pragma unroll
        for (int a = 0; a < 4; a++) {
          sc[a] = f32x4{0.f, 0.f, 0.f, 0.f};
#pragma unroll
          for (int ks = 0; ks < 2; ks++) {
            union { bf16x8 v; u32x4 u; } t; t.u = kn[g][a][ks];
            sc[a] = __builtin_amdgcn_mfma_f32_16x16x32_bf16(t.v, qh[g][ks], sc[a], 0, 0, 0);
          }
        }
#pragma unroll
        for (int kk = 0; kk < 2; kk++)
#pragma unroll
          for (int dt = 0; dt < 4; dt++) { union { bf16x8 v; u32x4 u; } t; t.u = vn[g][kk][dt]; vf[kk][dt] = t.v; }
        const bool forced_blk = (jthis == 0) || (jthis == curb) || (jthis == curb - 1);
        softmax_pv(sc, 64 * jthis, valid && (forced_blk || (qsel == qs)), tqs[g], 1 << 30, vf, os[g], ms[g], ls[g], quad);
        int nx = idx + 1;
        nx = nx < ntot[g] ? nx : ntot[g] - 1;
        const int j = __builtin_amdgcn_readfirstlane((nx < n0[g]) ? sel[(2 * g) * 16 + nx] : sel[(2 * g + 1) * 16 + (nx - n0[g])]);
        jn[g] = j;
        const u16* kp = ksb + (size_t)j * 4096;
        const u16* vp = vst + (size_t)j * 4096;
#pragma unroll
        for (int a = 0; a < 4; a++)
#pragma unroll
          for (int ks = 0; ks < 2; ks++) kn[g][a][ks] = *(const u32x4*)(kp + (a * 2 + ks) * 512);
#pragma unroll
        for (int kk = 0; kk < 2; kk++)
#pragma unroll
          for (int dt = 0; dt < 4; dt++) vn[g][kk][dt] = *(const u32x4*)(vp + (kk * 4 + dt) * 512);
      }
    }
#pragma unroll
    for (int g = 0; g < NG; g++) {
      float L = ls[g] + __shfl_xor(ls[g], 16);
      L += __shfl_xor(L, 32);
      const float g1 = gates[(size_t)tqs[g] * 48 + H * 3 + 1] / fmaxf(L, 1e-30f);
#pragma unroll
      for (int dt = 0; dt < 4; dt++) {
        const u32x2 v = *(const u32x2*)(part + (size_t)tqs[g] * 1024 + H * 64 + dt * 16 + 4 * quad);
        float y0 = __uint_as_float(v.x << 16) + g1 * os[g][dt][0];
        float y1 = __uint_as_float(v.x & 0xffff0000u) + g1 * os[g][dt][1];
        float y2 = __uint_as_float(v.y << 16) + g1 * os[g][dt][2];
        float y3 = __uint_as_float(v.y & 0xffff0000u) + g1 * os[g][dt][3];
        u32x2 o;
        o.x = pack2(y0, y1); o.y = pack2(y2, y3);
        *(u32x2*)(ya + (size_t)tqs[g] * 1024 + H * 64 + dt * 16 + 4 * quad) = o;
      }
    }
  }
}

__device__ __forceinline__ void gr_tile(const Params& p, int t, char* smem) {
  char* ws = p.ws;
  const int tid = otid(), lane = tid & 63, wave = tid >> 6, quad = lane >> 4, r16 = lane & 15;
  const int m0 = (t >> 3) * 128, nti = t & 7;
  const u16* hh = (const u16*)(ws + OFF_HH);
  const u16* w1 = (const u16*)((char*)p.out + OO_W1T);
  u16* dst = (u16*)(ws + OFF_G);
  f32x4 acc[2][8];
  zero_acc(acc);
  gemm_acc(acc, hh + (size_t)m0 * 1024, 1024, w1 + (size_t)(3968 + nti * 128) * 1024, 1024, 1024, (u16*)smem, nullptr);
#pragma unroll
  for (int mt = 0; mt < 2; mt++)
#pragma unroll
    for (int nt = 0; nt < 8; nt++)
#pragma unroll
      for (int i = 0; i < 4; i++)
        dst[(size_t)(m0 + wave * 32 + mt * 16 + quad * 4 + i) * 1024 + nti * 128 + nt * 16 + r16] = f2bf(siluf_(acc[mt][nt][i]));
}

__device__ __forceinline__ void phase3(const Params& p, char* smem) {
  char* ws = p.ws;
  const int tid = otid(), lane = tid & 63, wave = tid >> 6, quad = lane >> 4, r16 = lane & 15;
  const int bid = obid();
  if (bid < 64) {
    u16* ut = (u16*)((char*)p.out + OO_UT);
    u16* rtb = ut;
    const int e0 = (bid * 256 + tid) * 8;
    const float dc = __expf(logg_of(e0 >> 15) * 128.f);
    float r[8];
#pragma unroll
    for (int k = 0; k < 8; k++) r[k] = 0.f;
#pragma unroll 8
    for (int cch = 0; cch < 128; cch++) {
      const u32x4 u = *(const u32x4*)(ut + (size_t)cch * 131072 + e0);
      u32x4 o;
      o.x = pack2(r[0], r[1]); o.y = pack2(r[2], r[3]); o.z = pack2(r[4], r[5]); o.w = pack2(r[6], r[7]);
      *(u32x4*)(rtb + (size_t)cch * 131072 + e0) = o;
      r[0] = r[0] * dc + __uint_as_float(u.x << 16); r[1] = r[1] * dc + __uint_as_float(u.x & 0xffff0000u);
      r[2] = r[2] * dc + __uint_as_float(u.y << 16); r[3] = r[3] * dc + __uint_as_float(u.y & 0xffff0000u);
      r[4] = r[4] * dc + __uint_as_float(u.z << 16); r[5] = r[5] * dc + __uint_as_float(u.z & 0xffff0000u);
      r[6] = r[6] * dc + __uint_as_float(u.w << 16); r[7] = r[7] * dc + __uint_as_float(u.w & 0xffff0000u);
    }
  }
  unsigned* ctr = (unsigned*)(ws + OFF_CTR);
  volatile unsigned* stask = (volatile unsigned*)(smem + P3_TASK);
  {
  for (int pass = 0; pass < 2; pass++) {
    const int kvh = (bid & 1) ^ pass;
    while (true) {
      __syncthreads();
      if (tid == 0) *stask = atomicAdd(ctr + kvh, 1u);
      __syncthreads();
      const unsigned t = *stask;
      if (t >= (unsigned)(S_ / (8 * NG))) break;
      attn_tile_task(p, S_ / (8 * NG) - 1 - (int)t, kvh, smem);
    }
  }
  }
}

__device__ __forceinline__ void phase4(const Params& p, char* smem) {
  char* ws = p.ws;
  u16* sA = (u16*)smem;
  u16* sB = sA + 128 * LDT;
  const u16* hh = (const u16*)(ws + OFF_HH);
  const u16* w1 = (const u16*)((char*)p.out + OO_W1T);
  const u16* qr = (const u16*)(ws + OFF_QR);
  const u16* kr = (const u16*)(ws + OFF_KR);
  const u16* vrt = (const u16*)(ws + OFF_VRT);
  const u16* rtb = (const u16*)((char*)p.out + OO_UT);
  u16* pbuf = (u16*)(ws + OFF_PBUF);
  u16* yr = (u16*)(ws + OFF_YR);
  for (int task = obid(); task < 512; task += gridDim.x) {
    const int cch = task >> 2, hd = task & 3, m0 = cch * 128;
    const int tid = otid(), lane = tid & 63, wave = tid >> 6, quad = lane >> 4, r16 = lane & 15;
    const float logg = logg_of(hd);
    const int rloc = wave * 32 + quad * 4;
    const u16* gbuf = (const u16*)(ws + OFF_G);
    u16* pb = pbuf + (size_t)task * 16384;
    {
      f32x4 acc[2][8];
      zero_acc(acc);
      gemm_acc(acc, qr + (size_t)m0 * 512 + hd * 128, 512, kr + (size_t)m0 * 512 + hd * 128, 512, 128, sA, sB);
      float cf[8];
#pragma unroll
      for (int nt = 0; nt < 8; nt++) cf[nt] = __expf(-logg * (float)(nt * 16 + r16));
#pragma unroll
      for (int mt = 0; mt < 2; mt++)
#pragma unroll
        for (int i = 0; i < 4; i++) {
          const int ii = rloc + mt * 16 + i;
          const float rf = __expf(logg * (float)ii);
#pragma unroll
          for (int nt = 0; nt < 8; nt++) {
            const int jj = nt * 16 + r16;
            float v = (ii >= jj) ? acc[mt][nt][i] * rf * cf[nt] : 0.f;
            pb[ii * 128 + jj] = f2bf(v);
          }
        }
    }
    asm volatile("s_waitcnt vmcnt(0)" ::: "memory");
    __syncthreads();
    float s1[2][4], s2[2][4];
#pragma unroll
    for (int mt = 0; mt < 2; mt++)
#pragma unroll
      for (int i = 0; i < 4; i++) { s1[mt][i] = 0.f; s2[mt][i] = 0.f; }
#pragma unroll 1
    for (int dvt = 0; dvt < 2; dvt++) {
      f32x4 ao[2][8];
      zero_acc(ao);
      gemm_acc(ao, qr + (size_t)m0 * 512 + hd * 128, 512, rtb + ((size_t)(cch * 4 + hd) * 256 + dvt * 128) * 128, 128, 128, sA, sB);
#pragma unroll
      for (int mt = 0; mt < 2; mt++)
#pragma unroll
        for (int i = 0; i < 4; i++) {
          float dq = __expf(logg * (float)(rloc + mt * 16 + i + 1));
#pragma unroll
          for (int nt = 0; nt < 8; nt++) ao[mt][nt][i] *= dq;
        }
      gemm_acc(ao, pb, 128, vrt + (size_t)(hd * 256 + dvt * 128) * S_ + m0, S_, 128, sA, sB);
#pragma unroll
      for (int mt = 0; mt < 2; mt++)
#pragma unroll
        for (int i = 0; i < 4; i++)
#pragma unroll
          for (int nt = 0; nt < 8; nt++) {
            const float v = ao[mt][nt][i];
            s1[mt][i] += v; s2[mt][i] += v * v;
            yr[(size_t)(m0 + rloc + mt * 16 + i) * 1024 + hd * 256 + dvt * 128 + nt * 16 + r16] = f2bf(v);
          }
    }
#pragma unroll
    for (int mt = 0; mt < 2; mt++)
#pragma unroll
      for (int i = 0; i < 4; i++) {
        float a = s1[mt][i], b = s2[mt][i];
        a += __shfl_xor(a, 1); a += __shfl_xor(a, 2); a += __shfl_xor(a, 4); a += __shfl_xor(a, 8);
        b += __shfl_xor(b, 1); b += __shfl_xor(b, 2); b += __shfl_xor(b, 4); b += __shfl_xor(b, 8);
        const float mean = a * (1.f / 256.f);
        const float var = fmaxf(b * (1.f / 256.f) - mean * mean, 0.f);
        const float rstd = rsqrtf(var + 1e-6f);
        const size_t row = (size_t)(m0 + rloc + mt * 16 + i);
#pragma unroll
        for (int dvt = 0; dvt < 2; dvt++)
#pragma unroll
          for (int nt = 0; nt < 8; nt++) {
            const int cg = hd * 256 + dvt * 128 + nt * 16 + r16;
            const float gs = bf2f(gbuf[row * 1024 + cg]);
            u16* q = yr + row * 1024 + hd * 256 + dvt * 128 + nt * 16 + r16;
            *q = f2bf(gs * (bf2f(*q) - mean) * rstd);
          }
      }
  }
}

__device__ __forceinline__ void phase5(const Params& p, char* smem) {
  char* ws = p.ws;
  u16* sA = (u16*)smem;
  u16* sB = sA + 128 * LDT;
  const int tid = otid(), lane = tid & 63, wave = tid >> 6, quad = lane >> 4, r16 = lane & 15;
  const u16* hh = (const u16*)(ws + OFF_HH);
  const u16* w1 = (const u16*)((char*)p.out + OO_W1T);
  const u16* ya = (const u16*)(ws + OFF_QHI);
  const u16* yr = (const u16*)(ws + OFF_YR);
  const u16* wba = (const u16*)(ws + OFF_WBA);
  const u16* wbb = (const u16*)(ws + OFF_WBB);
  float* mf = (float*)(ws + OFF_MERGEDF);
  u16* mg = (u16*)(ws + OFF_MERGED);
  for (int it = 0;; it++) {
    int mtile, nti; bool valid;
    if (!next_tile(it, 128, 8, 8, 8, mtile, nti, valid)) break;
    if (!valid) continue;
    const int m0 = mtile * 128, n0 = nti * 128;
    const int rbase = m0 + wave * 32 + quad * 4;
    f32x4 acc[2][8];
    zero_acc(acc);
    gemm_acc(acc, hh + (size_t)m0 * 1024, 1024, w1 + (size_t)(6016 + n0) * 1024, 1024, 1024, sA, sB);
#pragma unroll
    for (int mt = 0; mt < 2; mt++)
#pragma unroll
      for (int nt = 0; nt < 8; nt++)
#pragma unroll
        for (int i = 0; i < 4; i++) mf[(size_t)(rbase + mt * 16 + i) * 1024 + n0 + nt * 16 + r16] = sigmoidf_(acc[mt][nt][i]);
    zero_acc(acc);
    gemm_acc(acc, yr + (size_t)m0 * 1024, 1024, wbb + (size_t)n0 * 1024, 1024, 1024, sA, sB);
#pragma unroll
    for (int mt = 0; mt < 2; mt++)
#pragma unroll
      for (int nt = 0; nt < 8; nt++)
#pragma unroll
        for (int i = 0; i < 4; i++) {
          const size_t idx = (size_t)(rbase + mt * 16 + i) * 1024 + n0 + nt * 16 + r16;
          mf[idx] = mf[idx] * acc[mt][nt][i];
        }
    zero_acc(acc);
    gemm_acc(acc, hh + (size_t)m0 * 1024, 1024, w1 + (size_t)(4992 + n0) * 1024, 1024, 1024, sA, sB);
#pragma unroll
    for (int mt = 0; mt < 2; mt++)
#pragma unroll
      for (int nt = 0; nt < 8; nt++)
#pragma unroll
        for (int i = 0; i < 4; i++) mg[(size_t)(rbase + mt * 16 + i) * 1024 + n0 + nt * 16 + r16] = f2bf(sigmoidf_(acc[mt][nt][i]));
    zero_acc(acc);
    gemm_acc(acc, ya + (size_t)m0 * 1024, 1024, wba + (size_t)n0 * 1024, 1024, 1024, sA, sB);
#pragma unroll
    for (int mt = 0; mt < 2; mt++)
#pragma unroll
      for (int nt = 0; nt < 8; nt++)
#pragma unroll
        for (int i = 0; i < 4; i++) {
          const size_t idx = (size_t)(rbase + mt * 16 + i) * 1024 + n0 + nt * 16 + r16;
          mg[idx] = f2bf(bf2f(mg[idx]) * acc[mt][nt][i] + mf[idx]);
        }
  }
}

__device__ __forceinline__ void phase_proj(const Params& p, char* smem, const u16* A, int K, const u16* Wt, float* dst, float* ssq) {
  u16* sA = (u16*)smem;
  for (int it = 0;; it++) {
    int mtile, npair; bool valid;
    if (!next_tile(it, 128, 4, 16, 4, mtile, npair, valid)) break;
    if (!valid) continue;
    const int tid = otid(), lane = tid & 63, wave = tid >> 6, quad = lane >> 4, r16 = lane & 15;
    const int m0 = mtile * 128, n0 = npair * 256;
    const int rbase = m0 + wave * 32 + quad * 4;
    f32x4 acc[2][16];
#pragma unroll
    for (int mt = 0; mt < 2; mt++)
#pragma unroll
      for (int nt = 0; nt < 16; nt++) acc[mt][nt] = f32x4{0.f, 0.f, 0.f, 0.f};
    gemm_acc_wide(acc, A + (size_t)m0 * K, K, Wt + (size_t)n0 * K, K, K, sA);
#pragma unroll
    for (int mt = 0; mt < 2; mt++)
#pragma unroll
      for (int i = 0; i < 4; i++) {
        float sq = 0.f;
#pragma unroll
        for (int nt = 0; nt < 16; nt++) {
          float v = acc[mt][nt][i];
          dst[(size_t)(rbase + mt * 16 + i) * 1024 + n0 + nt * 16 + r16] = v;
          sq += v * v;
        }
        sq += __shfl_xor(sq, 1); sq += __shfl_xor(sq, 2); sq += __shfl_xor(sq, 4); sq += __shfl_xor(sq, 8);
        if (r16 == 0) { ssq[(size_t)(rbase + mt * 16 + i) * 8 + 2 * npair] = sq; ssq[(size_t)(rbase + mt * 16 + i) * 8 + 2 * npair + 1] = 0.f; }
      }
  }
}

__device__ __forceinline__ void phase7(const Params& p) {
  char* ws = p.ws;
  const int lane = otid() & 63, wave = otid() >> 6;
  const int gw = obid() * 4 + wave, nw = gridDim.x * 4;
  const float* mix = (const float*)(ws + OFF_MIX);
  const float* ssq = (const float*)(ws + OFF_SSQ1);
  u16* h2 = (u16*)(ws + OFF_H2);
  for (int row0 = gw * 4; row0 < S_; row0 += nw * 4) {
    f32x4 xv[4][4], mv[4][4], g[4];
    float rs[4], s2[4];
#pragma unroll
    for (int r = 0; r < 4; r++)
#pragma unroll
      for (int i = 0; i < 4; i++) {
        xv[r][i] = ((const f32x4*)(p.x + (size_t)(row0 + r) * 1024))[lane + 64 * i];
        mv[r][i] = ((const f32x4*)(mix + (size_t)(row0 + r) * 1024))[lane + 64 * i];
      }
#pragma unroll
    for (int i = 0; i < 4; i++) g[i] = ((const f32x4*)p.g_post_mix)[lane + 64 * i];
#pragma unroll
    for (int r = 0; r < 4; r++) {
      float ss = 0.f;
#pragma unroll
      for (int i = 0; i < 8; i++) ss += ssq[(size_t)(row0 + r) * 8 + i];
      rs[r] = rsqrtf(ss * (1.f / 1024.f) + 1e-6f);
    }
#pragma unroll
    for (int r = 0; r < 4; r++) {
      s2[r] = 0.f;
#pragma unroll
      for (int i = 0; i < 4; i++) {
        f32x4 v = xv[r][i] + mv[r][i] * g[i] * rs[r];
        xv[r][i] = v;
        s2[r] += v[0] * v[0] + v[1] * v[1] + v[2] * v[2] + v[3] * v[3];
        ((f32x4*)(p.out + (size_t)(row0 + r) * 1024))[lane + 64 * i] = v;
      }
    }
#pragma unroll
    for (int o = 32; o >= 1; o >>= 1)
#pragma unroll
      for (int r = 0; r < 4; r++) s2[r] += __shfl_xor(s2[r], o);
#pragma unroll
    for (int i = 0; i < 4; i++) g[i] = ((const f32x4*)p.g_pre_ffn)[lane + 64 * i];
#pragma unroll
    for (int r = 0; r < 4; r++) {
      const float rs2 = rsqrtf(s2[r] * (1.f / 1024.f) + 1e-6f);
#pragma unroll
      for (int i = 0; i < 4; i++) {
        const f32x4 v = xv[r][i] * g[i] * rs2;
        u32x2 H;
        H.x = pack2(v[0], v[1]); H.y = pack2(v[2], v[3]);
        *(u32x2*)(h2 + (size_t)(row0 + r) * 1024 + (lane + 64 * i) * 4) = H;
      }
    }
  }
}

__device__ __forceinline__ void phase8(const Params& p, char* smem) {
  char* ws = p.ws;
  u16* sA = (u16*)smem;
  u16* sB = sA + 128 * LDT;
  const int tid = otid(), lane = tid & 63, wave = tid >> 6, quad = lane >> 4, r16 = lane & 15;
  const u16* h2 = (const u16*)(ws + OFF_H2);
  const u16* wgu = (const u16*)(ws + OFF_WGU);
  u16* act = (u16*)(ws + OFF_ACT);
  for (int it = 0;; it++) {
    int mtile, nti; bool valid;
    if (!next_tile(it, 128, 44, 16, 4, mtile, nti, valid)) break;
    if (!valid) continue;
    const int m0 = mtile * 128;
    const int rbase = m0 + wave * 32 + quad * 4;
    f32x4 acc[2][8];
    zero_acc(acc);
    gemm_acc(acc, h2 + (size_t)m0 * 1024, 1024, wgu + (size_t)(nti * 128) * 1024, 1024, 1024, sA, sB);
#pragma unroll
    for (int mt = 0; mt < 2; mt++)
#pragma unroll
      for (int nt = 0; nt < 4; nt++)
#pragma unroll
        for (int i = 0; i < 4; i++)
          act[(size_t)(rbase + mt * 16 + i) * 2816 + nti * 64 + nt * 16 + r16] = f2bf(siluf_(acc[mt][nt][i]) * acc[mt][nt + 4][i]);
  }
}

__device__ __forceinline__ void phase10(const Params& p) {
  char* ws = p.ws;
  const int lane = otid() & 63, wave = otid() >> 6;
  const int gw = obid() * 4 + wave, nw = gridDim.x * 4;
  const float* f = (const float*)(ws + OFF_F);
  const float* ssq = (const float*)(ws + OFF_SSQ2);
  for (int row0 = gw * 4; row0 < S_; row0 += nw * 4) {
    f32x4 xv[4][4], fv[4][4], g[4];
    float rs[4];
#pragma unroll
    for (int r = 0; r < 4; r++)
#pragma unroll
      for (int i = 0; i < 4; i++) {
        xv[r][i] = ((const f32x4*)(p.out + (size_t)(row0 + r) * 1024))[lane + 64 * i];
        fv[r][i] = ((const f32x4*)(f + (size_t)(row0 + r) * 1024))[lane + 64 * i];
      }
#pragma unroll
    for (int i = 0; i < 4; i++) g[i] = ((const f32x4*)p.g_post_ffn)[lane + 64 * i];
#pragma unroll
    for (int r = 0; r < 4; r++) {
      float ss = 0.f;
#pragma unroll
      for (int i = 0; i < 8; i++) ss += ssq[(size_t)(row0 + r) * 8 + i];
      rs[r] = rsqrtf(ss * (1.f / 1024.f) + 1e-6f);
    }
#pragma unroll
    for (int r = 0; r < 4; r++)
#pragma unroll
      for (int i = 0; i < 4; i++) ((f32x4*)(p.out + (size_t)(row0 + r) * 1024))[lane + 64 * i] = xv[r][i] + fv[r][i] * g[i] * rs[r];
  }
}

__device__ __forceinline__ void run_phase(const Params& p, int ph, char* smem) {
  switch (ph) {
    case 0: phase0(p, smem); break;
    case 1: phase1(p, smem); break;
    case 2: phase2(p, smem); phase2_ut(p, smem); for (int t = obid(); t < 1024; t += gridDim.x) gr_tile(p, t, smem); wconv_tasks(p, smem, 1760, 4640); break;
    case 3: phase3(p, smem); break;
    case 4: phase4(p, smem); break;
    case 5: phase5(p, smem); break;
    case 6: phase_proj(p, smem, (const u16*)(p.ws + OFF_MERGED), 1024, (const u16*)(p.ws + OFF_WOUT), (float*)(p.ws + OFF_MIX), (float*)(p.ws + OFF_SSQ1)); break;
    case 7: phase7(p); break;
    case 8: phase8(p, smem); break;
    case 9: phase_proj(p, smem, (const u16*)(p.ws + OFF_ACT), 2816, (const u16*)(p.ws + OFF_WD), (float*)(p.ws + OFF_F), (float*)(p.ws + OFF_SSQ2)); break;
    case 10: phase10(p); break;
  }
}

#define NPHASE 11

#if ONE_LAUNCH
#define XB_XCNT(j) (64 * (j))
#define XB_XSUB(j) (1024 + 64 * (j))
#define XB_XGEN(j) (2048 + 64 * (j))
#define XB_TOP 3072
#define XB_TOPGEN 3136
#define XB_WORDS 3200
__device__ __forceinline__ unsigned bar_ld(unsigned* p) { return __hip_atomic_load(p, __ATOMIC_RELAXED, __HIP_MEMORY_SCOPE_AGENT); }
__device__ __forceinline__ unsigned bar_add(unsigned* p) { return __hip_atomic_fetch_add(p, 1u, __ATOMIC_RELAXED, __HIP_MEMORY_SCOPE_AGENT); }
#define BAR_SPIN(cond) do { unsigned sp_ = 0; while (cond) { __builtin_amdgcn_s_sleep(1); if (++sp_ > (1u << 22)) break; } } while (0)
__device__ __forceinline__ unsigned xcc_id() { return (unsigned)__builtin_amdgcn_s_getreg((3 << 11) | 20) & 0xFu; }
__device__ __forceinline__ void fast_grid_barrier(unsigned* bar, unsigned x, volatile unsigned* st) {
  asm volatile("s_waitcnt vmcnt(0)" ::: "memory");
  __syncthreads();
  if (threadIdx.x == 0) {
    __builtin_amdgcn_s_waitcnt(0);
    unsigned nloc = st[0], nx = st[1];
    if (nloc == 0u) {
      const unsigned G = gridDim.x;
      unsigned sp = 0u;
      for (;;) {
        unsigned sum = 0u, cnt = 0u, mine = 0u;
#pragma unroll
        for (unsigned j = 0; j < 16; ++j) { const unsigned c = bar_ld(&bar[XB_XCNT(j)]); sum += c; cnt += (c > 0u) ? 1u : 0u; mine = (j == x) ? c : mine; }
        nloc = mine > 0u ? mine : 1u; nx = cnt > 0u ? cnt : 1u;
        if (sum == G) break;
        __builtin_amdgcn_s_sleep(1);
        if (++sp > (1u << 22)) break;
      }
      st[0] = nloc; st[1] = nx;
    }
    const unsigned old = bar_add(&bar[XB_XSUB(x)]);
    const unsigned gen = old / nloc;
    if (old + 1u == (gen + 1u) * nloc) {
      __builtin_amdgcn_fence(__ATOMIC_RELEASE, "agent");
      asm volatile("s_waitcnt vmcnt(0)" ::: "memory");
      const unsigned og = bar_add(&bar[XB_TOP]);
      const unsigned tg = og / nx;
      if (og + 1u == (tg + 1u) * nx) bar_add(&bar[XB_TOPGEN]);
      else BAR_SPIN(bar_ld(&bar[XB_TOPGEN]) == tg);
      __builtin_amdgcn_fence(__ATOMIC_ACQUIRE, "agent");
      bar_add(&bar[XB_XGEN(x)]);
      asm volatile("s_waitcnt vmcnt(0)" ::: "memory");
    } else {
      BAR_SPIN(bar_ld(&bar[XB_XGEN(x)]) == gen);
      __builtin_amdgcn_fence(__ATOMIC_ACQUIRE, "agent");
      asm volatile("s_waitcnt vmcnt(0)" ::: "memory");
    }
  }
  __syncthreads();
}

__global__ void __launch_bounds__(256, 2) mega_kernel(Params p) {
  extern __shared__ __attribute__((aligned(16))) char smem[];
  cg::grid_group grid = cg::this_grid();
#ifndef REPMASK
#define REPMASK 0
#endif
  if (threadIdx.x == 0) {
    volatile unsigned* bst = (volatile unsigned*)(smem + 73728);
    bst[0] = 0u; bst[1] = 0u;
    bar_add((unsigned*)(p.ws + OFF_BAR) + XB_XCNT(xcc_id()));
  }
  __syncthreads();
  for (int ph = 0; ph < NPHASE; ph++) {
    run_phase(p, ph, smem);
    if ((REPMASK >> ph) & 1) { grid.sync(); run_phase(p, ph, smem); }
    if (ph + 1 < NPHASE) fast_grid_barrier((unsigned*)(p.ws + OFF_BAR), xcc_id(), (volatile unsigned*)(smem + 73728));
    if (p.ws == nullptr) grid.sync();
  }
}

#else
template <int PH>
__global__ void __launch_bounds__(256, 2) phase_kernel(Params p) {
  extern __shared__ __attribute__((aligned(16))) char smem[];
  run_phase(p, PH, smem);
}

#endif

extern "C" void kernel_launch(void* const* d_in, const int* in_sizes, int n_in, void* d_out, int out_size, void* d_ws, size_t ws_size,
                              hipStream_t stream) {
  Params p{};
  p.x = (const float*)d_in[0]; p.g_pre_mix = (const float*)d_in[1]; p.w_in = (const float*)d_in[2];
  p.cpk = (const float*)d_in[3]; p.cw1k = (const float*)d_in[4]; p.cw2k = (const float*)d_in[5];
  p.cpv = (const float*)d_in[6]; p.cw1v = (const float*)d_in[7]; p.cw2v = (const float*)d_in[8];
  p.wba = (const float*)d_in[9]; p.wbb = (const float*)d_in[10]; p.wout = (const float*)d_in[11];
  p.g_post_mix = (const float*)d_in[12]; p.g_pre_ffn = (const float*)d_in[13];
  p.wg = (const float*)d_in[14]; p.wu = (const float*)d_in[15]; p.wd = (const float*)d_in[16]; p.g_post_ffn = (const float*)d_in[17];
  p.out = (float*)d_out; p.ws = (char*)d_ws;
#if ONE_LAUNCH
  static int grid_blocks = 0;
  if (!grid_blocks) {
    int dev = 0, cus = 0, per_cu = 0;
    hipGetDevice(&dev);
    hipDeviceGetAttribute(&cus, hipDeviceAttributeMultiprocessorCount, dev);
    hipFuncSetAttribute((const void*)mega_kernel, hipFuncAttributeMaxDynamicSharedMemorySize, SMEM_BYTES);
    hipOccupancyMaxActiveBlocksPerMultiprocessor(&per_cu, mega_kernel, 256, SMEM_BYTES);
    if (per_cu > 2) per_cu = 2;
    if (per_cu < 1) per_cu = 1;
    grid_blocks = cus * per_cu;
  }
  hipMemsetAsync((char*)d_ws + OFF_CTR, 0, 4096 + 4 * XB_WORDS, stream);
  void* args[] = {&p};
  hipError_t e = hipLaunchCooperativeKernel((void*)mega_kernel, dim3(grid_blocks), dim3(256), args, SMEM_BYTES, stream);
  if (e != hipSuccess) fprintf(stderr, "cooperative launch failed: %s (grid %d)\n", hipGetErrorString(e), grid_blocks);
#else
  hipLaunchKernelGGL(phase_kernel<0>, dim3(512), dim3(256), SMEM_BYTES, stream, p);
  hipLaunchKernelGGL(phase_kernel<1>, dim3(512), dim3(256), SMEM_BYTES, stream, p);
  hipLaunchKernelGGL(phase_kernel<2>, dim3(512), dim3(256), SMEM_BYTES, stream, p);
  hipLaunchKernelGGL(phase_kernel<3>, dim3(512), dim3(256), SMEM_BYTES, stream, p);
  hipLaunchKernelGGL(phase_kernel<4>, dim3(512), dim3(256), SMEM_BYTES, stream, p);
  hipLaunchKernelGGL(phase_kernel<5>, dim3(512), dim3(256), SMEM_BYTES, stream, p);
  hipLaunchKernelGGL(phase_kernel<6>, dim3(512), dim3(256), SMEM_BYTES, stream, p);
  hipLaunchKernelGGL(phase_kernel<7>, dim3(512), dim3(256), SMEM_BYTES, stream, p);
  hipLaunchKernelGGL(phase_kernel<8>, dim3(512), dim3(256), SMEM_BYTES, stream, p);
  hipLaunchKernelGGL(phase_kernel<9>, dim3(512), dim3(256), SMEM_BYTES, stream, p);
  hipLaunchKernelGGL(phase_kernel<10>, dim3(512), dim3(256), SMEM_BYTES, stream, p);
#endif
}
```

```cpp
#include <hip/hip_runtime.h>
#include <hip/hip_bf16.h>
#include <hip/hip_cooperative_groups.h>
#include <cstdio>
namespace cg = cooperative_groups;

#ifndef ONE_LAUNCH
#define ONE_LAUNCH 1
#endif

typedef unsigned short u16;
using bf16x8 = __attribute__((ext_vector_type(8))) short;
using f32x4 = __attribute__((ext_vector_type(4))) float;
using u32x4 = __attribute__((ext_vector_type(4))) unsigned;
using u32x2 = __attribute__((ext_vector_type(2))) unsigned;
using f16x8 = __attribute__((ext_vector_type(8))) _Float16;

#define S_ 16384
#define NEGF (-1e30f)
#define BIGF (1e9f)

struct Params {
  const float *x, *g_pre_mix, *w_in, *cpk, *cw1k, *cw2k, *cpv, *cw1v, *cw2v, *wba, *wbb, *wout, *g_post_mix, *g_pre_ffn, *wg, *wu, *wd, *g_post_ffn;
  float* out;
  char* ws;
};

constexpr size_t MB = (size_t)1 << 20;
constexpr size_t OFF_HH = 0, OFF_HL = 32 * MB, OFF_RTB = 32 * MB, OFF_QHI = 64 * MB, OFF_QLO = 96 * MB, OFF_YR = 96 * MB,
                 OFF_QR = 128 * MB, OFF_KR = 144 * MB, OFF_KRTD = 160 * MB, OFF_VRT = 176 * MB, OFF_KS = 208 * MB, OFF_KW = 212 * MB,
                 OFF_VST = 216 * MB, OFF_VWT = 220 * MB, OFF_PBUF = 208 * MB, OFF_GATES = 224 * MB, OFF_KCH = 227 * MB,
                 OFF_KCL = 227 * MB + 256 * 1024, OFF_VCT = 227 * MB + 512 * 1024, OFF_WBA = 228 * MB, OFF_WBB = 230 * MB,
                 OFF_WOUT = 232 * MB, OFF_WGU = 234 * MB, OFF_WD = 245 * MB, OFF_W1LO = 250 * MB + 512 * 1024,
                 OFF_SSQ1 = 253 * MB, OFF_SSQ2 = 253 * MB + 512 * 1024, OFF_CTR = 254 * MB, OFF_BAR = 254 * MB + 4096,
                 OFF_MERGEDF = 128 * MB, OFF_MERGED = 32 * MB, OFF_MIX = 128 * MB, OFF_H2 = 0, OFF_ACT = 32 * MB, OFF_F = 128 * MB;
constexpr size_t OO_W1T = 0, OO_CS64 = 14 * MB, OO_CS128 = 18 * MB, OO_UT = 14 * MB, OO_KC = 46 * MB, OO_VC = 54 * MB, OO_GB = 46 * MB;
constexpr size_t OFF_G = 32 * MB;
constexpr size_t OFF_GA = 160 * MB;

__device__ __forceinline__ int otid() { int t = threadIdx.x; asm volatile("" : "+v"(t)); return t; }
__device__ __forceinline__ int obid() { int b = blockIdx.x; asm volatile("" : "+s"(b)); return b; }
__device__ __forceinline__ u16 f2bf(float f) {
  unsigned u = __float_as_uint(f);
  u += 0x7fffu + ((u >> 16) & 1u);
  return (u16)(u >> 16);
}
__device__ __forceinline__ u16 f2h(float f) { union { _Float16 h; u16 u; } t; t.h = (_Float16)f; return t.u; }
__device__ __forceinline__ unsigned packh2(float a, float b) { return (unsigned)f2h(a) | ((unsigned)f2h(b) << 16); }
__device__ __forceinline__ f32x4 mfma16(bf16x8 a, bf16x8 b, f32x4 c) {
  union { bf16x8 s; f16x8 h; } ta, tb; ta.s = a; tb.s = b;
  return __builtin_amdgcn_mfma_f32_16x16x32_f16(ta.h, tb.h, c, 0, 0, 0);
}
__device__ __forceinline__ float bf2f(u16 h) { return __uint_as_float(((unsigned)h) << 16); }
__device__ __forceinline__ unsigned pack2(float a, float b) { return (unsigned)f2bf(a) | ((unsigned)f2bf(b) << 16); }
__device__ __forceinline__ float sigmoidf_(float x) { return 1.f / (1.f + __expf(-x)); }
__device__ __forceinline__ float siluf_(float x) { return x / (1.f + __expf(-x)); }

__device__ __forceinline__ float logg_of(int hd) {
  return hd == 0 ? -0.0317486972f : (hd == 1 ? -0.0157483574f : (hd == 2 ? -0.00784317777f : -0.00391389942f));
}

#define BK 64
#define LDT 72
#define SMEM_BYTES 73744

__device__ __forceinline__ void zero_acc(f32x4 (&acc)[2][8]) {
#pragma unroll
  for (int a = 0; a < 2; a++)
#pragma unroll
    for (int b = 0; b < 8; b++) acc[a][b] = f32x4{0.f, 0.f, 0.f, 0.f};
}

#define GBUF (2 * 128 * LDT)
__device__ __forceinline__ void gemm_store(const u32x4 (&ra)[4], const u32x4 (&rb)[4], u16* sA, int lrow, int lc) {
#pragma unroll
  for (int i = 0; i < 4; i++) {
    *(u32x4*)(sA + (lrow + i * 32) * LDT + lc) = ra[i];
    *(u32x4*)(sA + 128 * LDT + (lrow + i * 32) * LDT + lc) = rb[i];
  }
}
__device__ __forceinline__ void gemm_load(u32x4 (&ra)[4], u32x4 (&rb)[4], const u16* pa, const u16* pb, int lda, int ldb) {
#pragma unroll
  for (int i = 0; i < 4; i++) {
    ra[i] = *(const u32x4*)(pa + (size_t)(i * 32) * lda);
    rb[i] = *(const u32x4*)(pb + (size_t)(i * 32) * ldb);
  }
}
template <bool F16>
__device__ __forceinline__ void gemm_compute(f32x4 (&acc)[2][8], const u16* sA, int wave, int quad, int r16) {
  const u16* sB = sA + 128 * LDT;
  __builtin_amdgcn_s_setprio(2);
#pragma unroll
  for (int ks = 0; ks < 2; ks++) {
    bf16x8 af[2];
#pragma unroll
    for (int mt = 0; mt < 2; mt++) af[mt] = *(const bf16x8*)(sA + (wave * 32 + mt * 16 + r16) * LDT + ks * 32 + quad * 8);
#pragma unroll
    for (int nh = 0; nh < 2; nh++) {
      bf16x8 bfr[4];
#pragma unroll
      for (int nt = 0; nt < 4; nt++) bfr[nt] = *(const bf16x8*)(sB + ((nh * 4 + nt) * 16 + r16) * LDT + ks * 32 + quad * 8);
#pragma unroll
      for (int mt = 0; mt < 2; mt++)
#pragma unroll
        for (int nt = 0; nt < 4; nt++)
          acc[mt][nh * 4 + nt] = F16 ? mfma16(af[mt], bfr[nt], acc[mt][nh * 4 + nt])
                                     : __builtin_amdgcn_mfma_f32_16x16x32_bf16(af[mt], bfr[nt], acc[mt][nh * 4 + nt], 0, 0, 0);
    }
  }
  __builtin_amdgcn_s_setprio(0);
}

template <bool F16 = false>
__device__ __forceinline__ void gemm_acc(f32x4 (&acc)[2][8], const u16* A, int lda, const u16* B, int ldb, int K, u16* sA, u16*  ) {
  const int tid = otid(), lane = tid & 63, wave = tid >> 6, quad = lane >> 4, r16 = lane & 15;
  const int lrow = tid >> 3, lc = (tid & 7) * 8;
  const u16* pa = A + (size_t)lrow * lda + lc;
  const u16* pb = B + (size_t)lrow * ldb + lc;
  u16* s0 = sA;
  u16* s1 = sA + GBUF;
  u32x4 ra0[4], rb0[4], ra1[4], rb1[4];
  const int nk = K / BK;
  gemm_load(ra0, rb0, pa, pb, lda, ldb);
  gemm_load(ra1, rb1, pa + BK, pb + BK, lda, ldb);
  __syncthreads();
  gemm_store(ra0, rb0, s0, lrow, lc);
  if (nk > 2) gemm_load(ra0, rb0, pa + 2 * BK, pb + 2 * BK, lda, ldb);
  __syncthreads();
  for (int kt = 0; kt < nk; kt += 2) {
    gemm_compute<F16>(acc, s0, wave, quad, r16);
    __builtin_amdgcn_sched_barrier(0);
    gemm_store(ra1, rb1, s1, lrow, lc);
    if (kt + 3 < nk) gemm_load(ra1, rb1, pa + (kt + 3) * BK, pb + (kt + 3) * BK, lda, ldb);
    __syncthreads();
    gemm_compute<F16>(acc, s1, wave, quad, r16);
    __builtin_amdgcn_sched_barrier(0);
    if (kt + 2 < nk) {
      gemm_store(ra0, rb0, s0, lrow, lc);
      if (kt + 4 < nk) gemm_load(ra0, rb0, pa + (kt + 4) * BK, pb + (kt + 4) * BK, lda, ldb);
    }
    __syncthreads();
  }
}

__device__ __forceinline__ void gemm_acc_wide(f32x4 (&acc)[2][16], const u16* A, int lda, const u16* B, int ldb, int K, u16* sA) {
  const int tid = otid(), lane = tid & 63, wave = tid >> 6, quad = lane >> 4, r16 = lane & 15;
  const int lrow = tid >> 3, lc = (tid & 7) * 8;
  const u16* pa = A + (size_t)lrow * lda + lc;
  const u16* pb = B + (size_t)lrow * ldb + lc;
  u16* sB = sA + 128 * LDT;
  u32x4 ra[4], rb[8];
#pragma unroll
  for (int i = 0; i < 4; i++) ra[i] = *(const u32x4*)(pa + (size_t)(i * 32) * lda);
#pragma unroll
  for (int i = 0; i < 8; i++) rb[i] = *(const u32x4*)(pb + (size_t)(i * 32) * ldb);
  const int nk = K / BK;
  for (int kt = 0; kt < nk; kt++) {
    __syncthreads();
#pragma unroll
    for (int i = 0; i < 4; i++) *(u32x4*)(sA + (lrow + i * 32) * LDT + lc) = ra[i];
#pragma unroll
    for (int i = 0; i < 8; i++) *(u32x4*)(sB + (lrow + i * 32) * LDT + lc) = rb[i];
    __syncthreads();
    if (kt + 1 < nk) {
      pa += BK; pb += BK;
#pragma unroll
      for (int i = 0; i < 4; i++) ra[i] = *(const u32x4*)(pa + (size_t)(i * 32) * lda);
#pragma unroll
      for (int i = 0; i < 8; i++) rb[i] = *(const u32x4*)(pb + (size_t)(i * 32) * ldb);
    }
    __builtin_amdgcn_s_setprio(2);
#pragma unroll
    for (int ks = 0; ks < 2; ks++) {
      bf16x8 af[2];
#pragma unroll
      for (int mt = 0; mt < 2; mt++) af[mt] = *(const bf16x8*)(sA + (wave * 32 + mt * 16 + r16) * LDT + ks * 32 + quad * 8);
#pragma unroll
      for (int nq = 0; nq < 4; nq++) {
        bf16x8 bfr[4];
#pragma unroll
        for (int nt = 0; nt < 4; nt++) bfr[nt] = *(const bf16x8*)(sB + ((nq * 4 + nt) * 16 + r16) * LDT + ks * 32 + quad * 8);
#pragma unroll
        for (int mt = 0; mt < 2; mt++)
#pragma unroll
          for (int nt = 0; nt < 4; nt++)
            acc[mt][nq * 4 + nt] = __builtin_amdgcn_mfma_f32_16x16x32_bf16(af[mt], bfr[nt], acc[mt][nq * 4 + nt], 0, 0, 0);
      }
    }
    __builtin_amdgcn_s_setprio(0);
  }
  __syncthreads();
}

__device__ const float ROPE_INV[96] = {1.0f, 0.749894202f, 0.562341332f, 0.421696514f, 0.316227764f, 0.237137377f, 0.177827939f, 0.133352146f, 0.100000001f, 0.0749894232f, 0.0562341325f, 0.0421696492f, 0.0316227749f, 0.0237137377f, 0.0177827943f, 0.013335214f, 0.00999999978f, 0.00749894232f, 0.00562341325f, 0.00421696482f, 0.00316227763f, 0.00237137382f, 0.00177827943f, 0.00133352145f, 0.00100000005f, 0.000749894185f, 0.000562341302f, 0.000421696517f, 0.000316227757f, 0.00023713737f, 0.00017782794f, 0.00013335215f, 1.0f, 0.865964353f, 0.749894202f, 0.649381638f, 0.562341332f, 0.486967534f, 0.421696514f, 0.365174115f, 0.316227764f, 0.273841977f, 0.237137377f, 0.2053525f, 0.177827939f, 0.153992653f, 0.133352146f, 0.115478195f, 0.100000001f, 0.0865964293f, 0.0749894232f, 0.0649381652f, 0.0562341325f, 0.0486967526f, 0.0421696492f, 0.0365174115f, 0.0316227749f, 0.0273841955f, 0.0237137377f, 0.0205352511f, 0.0177827943f, 0.0153992651f, 0.013335214f, 0.0115478197f, 0.00999999978f, 0.00865964312f, 0.00749894232f, 0.00649381615f, 0.00562341325f, 0.00486967526f, 0.00421696482f, 0.00365174119f, 0.00316227763f, 0.00273841969f, 0.00237137382f, 0.00205352507f, 0.00177827943f, 0.00153992651f, 0.00133352145f, 0.00115478202f, 0.00100000005f, 0.000865964335f, 0.000749894185f, 0.000649381604f, 0.000562341302f, 0.000486967532f, 0.000421696517f, 0.000365174114f, 0.000316227757f, 0.000273841957f, 0.00023713737f, 0.00020535251f, 0.00017782794f, 0.00015399266f, 0.00013335215f, 0.0001154782f};

__device__ __forceinline__ bool next_tile(int it, int Mt, int Nt, int SM, int SN, int& mt, int& nt, bool& valid) {
  const int G = gridDim.x, bid = obid();
  if (G == 512) {
    const int xcd = bid & 7, l = bid >> 3;
    const int nsm = (Mt + SM - 1) / SM, nsn = (Nt + SN - 1) / SN;
    const int sb = it * 8 + xcd;
    if (sb >= nsm * nsn) return false;
    const int sm = sb % nsm, sn = sb / nsm;
    mt = sm * SM + l / SN; nt = sn * SN + l % SN;
    valid = (mt < Mt) && (nt < Nt);
    return true;
  } else {
    const int task = bid + it * G;
    if (task >= Mt * Nt) return false;
    mt = task / Nt; nt = task % Nt; valid = true;
    return true;
  }
}

__device__ __forceinline__ void tconv_tile(const float* src, int ld_src, int k0, int n_src0, int nvalid, u16* dst_hi, u16* dst_lo, int ld_dst,
                                           int n_dst0, float* tile) {
  const int tid = otid();
  __syncthreads();
#pragma unroll
  for (int i = 0; i < 4; i++) {
    const int r = i * 16 + (tid >> 4), c = (tid & 15) * 4;
    float4 v = float4{0.f, 0.f, 0.f, 0.f};
    if (c < nvalid) v = *(const float4*)(src + (size_t)(k0 + r) * ld_src + n_src0 + c);
    tile[r * 65 + c] = v.x; tile[r * 65 + c + 1] = v.y; tile[r * 65 + c + 2] = v.z; tile[r * 65 + c + 3] = v.w;
  }
  __syncthreads();
  const int n = tid >> 2, kc = (tid & 3) * 16;
  unsigned hi[8], lo[8];
#pragma unroll
  for (int e = 0; e < 8; e++) {
    float a = tile[(kc + 2 * e) * 65 + n], b = tile[(kc + 2 * e + 1) * 65 + n];
    u16 ah = f2bf(a), bh = f2bf(b);
    hi[e] = (unsigned)ah | ((unsigned)bh << 16);
    lo[e] = packh2(a, b);
  }
  u16* d = dst_hi + (size_t)(n_dst0 + n) * ld_dst + k0 + kc;
  *(uint4*)d = uint4{hi[0], hi[1], hi[2], hi[3]};
  *(uint4*)(d + 8) = uint4{hi[4], hi[5], hi[6], hi[7]};
  if (dst_lo) {
    u16* dl = dst_lo + (size_t)(n_dst0 + n) * ld_dst + k0 + kc;
    *(uint4*)dl = uint4{lo[0], lo[1], lo[2], lo[3]};
    *(uint4*)(dl + 8) = uint4{lo[4], lo[5], lo[6], lo[7]};
  }
}

__device__ __forceinline__ void phase0(const Params& p, char* smem) {
  char* ws = p.ws;
  char* oo = (char*)p.out;
  float* tile = (float*)smem;
  const int tid = otid(), lane = tid & 63, wave = tid >> 6;
  if (obid() == 0 && tid < 4) ((unsigned*)(ws + OFF_CTR))[tid] = 0u;
  for (int task = obid(); task < 4640; task += gridDim.x) {
    if (task < 1760) {
      int a = task >> 4, kt = task & 15;
      int nd = a * 64, ns, nv = 64;
      if (nd < 1792) ns = nd;
      else if (nd == 1792) { ns = 1792; nv = 48; }
      else if (nd == 1856) { ns = 0; nv = 0; }
      else ns = nd - 80;
      tconv_tile(p.w_in, 6960, kt * 64, ns, nv, (u16*)(oo + OO_W1T), (nd < 1152) ? (u16*)(ws + OFF_W1LO) : nullptr, 1024, nd, tile);
    } else if (task < 1760 + 768) {
      int t = task - 1760, wsel = t >> 8, r = t & 255, a = r >> 4, kt = r & 15;
      const float* src = wsel == 0 ? p.wba : (wsel == 1 ? p.wbb : p.wout);
      u16* dst = (u16*)(ws + (wsel == 0 ? OFF_WBA : (wsel == 1 ? OFF_WBB : OFF_WOUT)));
      tconv_tile(src, 1024, kt * 64, a * 64, 64, dst, nullptr, 1024, a * 64, tile);
    } else if (task < 1760 + 768 + 1408) {
      int t = task - 2528, a = t >> 4, kt = t & 15;
      const float* src = (a & 1) ? p.wu : p.wg;
      tconv_tile(src, 2816, kt * 64, (a >> 1) * 64, 64, (u16*)(ws + OFF_WGU), nullptr, 1024, a * 64, tile);
    } else {
      int t = task - 3936, a = t / 44, kt = t % 44;
      tconv_tile(p.wd, 1024, kt * 64, a * 64, 64, (u16*)(ws + OFF_WD), nullptr, 2816, a * 64, tile);
    }
  }
  const int gw = obid() * 4 + wave, nw = gridDim.x * 4;
  u16* hh = (u16*)(ws + OFF_HH);
  u16* hl = (u16*)(ws + OFF_HL);
  for (int row0 = gw * 4; row0 < S_; row0 += nw * 4) {
    f32x4 v[4][4], g[4];
    float ss[4];
#pragma unroll
    for (int r = 0; r < 4; r++)
#pragma unroll
      for (int i = 0; i < 4; i++) v[r][i] = ((const f32x4*)(p.x + (size_t)(row0 + r) * 1024))[lane + 64 * i];
#pragma unroll
    for (int i = 0; i < 4; i++) g[i] = ((const f32x4*)p.g_pre_mix)[lane + 64 * i];
#pragma unroll
    for (int r = 0; r < 4; r++) {
      ss[r] = 0.f;
#pragma unroll
      for (int i = 0; i < 4; i++) ss[r] += v[r][i][0] * v[r][i][0] + v[r][i][1] * v[r][i][1] + v[r][i][2] * v[r][i][2] + v[r][i][3] * v[r][i][3];
    }
#pragma unroll
    for (int o = 32; o >= 1; o >>= 1)
#pragma unroll
      for (int r = 0; r < 4; r++) ss[r] += __shfl_xor(ss[r], o);
#pragma unroll
    for (int r = 0; r < 4; r++) {
      const float rs = rsqrtf(ss[r] * (1.f / 1024.f) + 1e-6f);
#pragma unroll
      for (int i = 0; i < 4; i++) {
        const f32x4 y = v[r][i] * rs * g[i];
        u32x2 H, L;
        H.x = pack2(y[0], y[1]); H.y = pack2(y[2], y[3]);
        L.x = packh2(y[0], y[1]); L.y = packh2(y[2], y[3]);
        *(u32x2*)(hh + (size_t)(row0 + r) * 1024 + (lane + 64 * i) * 4) = H;
        *(u32x2*)(hl + (size_t)(row0 + r) * 1024 + (lane + 64 * i) * 4) = L;
      }
    }
  }
  float2* cs64 = (float2*)(oo + OO_CS64);
  float2* cs128 = (float2*)(oo + OO_CS128);
  const int gt = obid() * 256 + tid, nt = gridDim.x * 256;
  for (int e = gt; e < S_ * 96; e += nt) {
    int t = e / 96, i = e % 96;
    float ang = (float)t * ROPE_INV[i];
    float sn, cn;
    sincosf(ang, &sn, &cn);
    if (i < 32) cs64[t * 32 + i] = float2{cn, sn};
    else cs128[t * 64 + (i - 32)] = float2{cn, sn};
  }
}

__device__ __forceinline__ void p1_epilogue(const Params& p, int nti, int m0, f32x4 (&acc)[2][8]) {
  char* ws = p.ws;
  char* oo = (char*)p.out;
  const int tid = otid(), lane = tid & 63, wave = tid >> 6, quad = lane >> 4, r16 = lane & 15;
  const int rbase = m0 + wave * 32 + quad * 4;
  const bool rope64 = (nti <= 8) || nti == 10 || nti == 12;
  const bool rope128 = (nti >= 15 && nti <= 22);
  if (rope64) {
    const float2* cs64 = (const float2*)(oo + OO_CS64);
#pragma unroll
    for (int mt = 0; mt < 2; mt++)
#pragma unroll
      for (int i = 0; i < 4; i++) {
        int tok = rbase + mt * 16 + i;
#pragma unroll
        for (int j = 0; j < 2; j++) {
          float2 cs = cs64[tok * 32 + j * 16 + r16];
#pragma unroll
          for (int hh = 0; hh < 2; hh++) {
            float x1 = acc[mt][hh * 4 + j][i], x2 = acc[mt][hh * 4 + j + 2][i];
            acc[mt][hh * 4 + j][i] = x1 * cs.x - x2 * cs.y;
            acc[mt][hh * 4 + j + 2][i] = x2 * cs.x + x1 * cs.y;
          }
        }
      }
  } else if (rope128) {
    const float2* cs128 = (const float2*)(oo + OO_CS128);
    const float sc = (nti <= 18) ? 0.08838834764831845f : 1.f;
#pragma unroll
    for (int mt = 0; mt < 2; mt++)
#pragma unroll
      for (int i = 0; i < 4; i++) {
        int tok = rbase + mt * 16 + i;
#pragma unroll
        for (int j = 0; j < 4; j++) {
          float2 cs = cs128[tok * 64 + j * 16 + r16];
          float x1 = acc[mt][j][i], x2 = acc[mt][j + 4][i];
          acc[mt][j][i] = (x1 * cs.x - x2 * cs.y) * sc;
          acc[mt][j + 4][i] = (x2 * cs.x + x1 * cs.y) * sc;
        }
      }
  }
  if (nti < 8) {
    u16* qh = (u16*)(ws + OFF_QHI);
    u16* ql = (u16*)(ws + OFF_QLO);
#pragma unroll
    for (int mt = 0; mt < 2; mt++)
#pragma unroll
      for (int nt = 0; nt < 8; nt++)
#pragma unroll
        for (int i = 0; i < 4; i++) {
          int tok = rbase + mt * 16 + i, col = nti * 128 + nt * 16 + r16;
          float v = acc[mt][nt][i];
          qh[(size_t)tok * 1024 + col] = f2bf(v);
          ql[(size_t)tok * 1024 + col] = f2h(v);
        }
  } else if (nti == 8 || nti == 9) {
    float* dst = (float*)(oo + (nti == 8 ? OO_KC : OO_VC));
#pragma unroll
    for (int mt = 0; mt < 2; mt++)
#pragma unroll
      for (int nt = 0; nt < 8; nt++)
#pragma unroll
        for (int i = 0; i < 4; i++) dst[(size_t)(rbase + mt * 16 + i) * 128 + nt * 16 + r16] = acc[mt][nt][i];
  } else if (nti == 10) {
    u16* dst = (u16*)(ws + OFF_KS);
#pragma unroll
    for (int mt = 0; mt < 2; mt++)
#pragma unroll
      for (int nt = 0; nt < 8; nt++)
#pragma unroll
        for (int i = 0; i < 4; i++) {
          const int tok = rbase + mt * 16 + i, col = nt * 16 + r16;
          const int kvh = col >> 6, d = col & 63;
          const size_t idx = (((((size_t)kvh * 256 + (tok >> 6)) * 4 + ((tok >> 4) & 3)) * 2 + (d >> 5)) * 64 + ((d >> 3) & 3) * 16 + (tok & 15)) * 8 + (d & 7);
          dst[idx] = f2bf(acc[mt][nt][i]);
        }
  } else if (nti == 12) {
    u16* dst = (u16*)(ws + OFF_KW);
#pragma unroll
    for (int mt = 0; mt < 2; mt++)
#pragma unroll
      for (int nt = 0; nt < 8; nt++)
#pragma unroll
        for (int i = 0; i < 4; i++) dst[(size_t)(rbase + mt * 16 + i) * 128 + nt * 16 + r16] = f2bf(acc[mt][nt][i]);
  } else if (nti == 11) {
    u16* dst = (u16*)(ws + OFF_VST);
#pragma unroll
    for (int mt = 0; mt < 2; mt++)
#pragma unroll
      for (int nt = 0; nt < 8; nt++) {
        const int tok = rbase + mt * 16, col = nt * 16 + r16;
        const int kvh = col >> 6, d = col & 63, kap = tok & 63;
        const int kk = kap >> 5, half = (kap >> 4) & 1, q = (kap >> 2) & 3;
        const size_t idx = (((((size_t)kvh * 256 + (tok >> 6)) * 2 + kk) * 4 + (d >> 4)) * 64 + q * 16 + (d & 15)) * 8 + 4 * half;
        uint2 v;
        v.x = pack2(acc[mt][nt][0], acc[mt][nt][1]);
        v.y = pack2(acc[mt][nt][2], acc[mt][nt][3]);
        *(uint2*)(dst + idx) = v;
      }
  } else if (nti == 13) {
    u16* dst = (u16*)(ws + OFF_VWT);
#pragma unroll
    for (int mt = 0; mt < 2; mt++)
#pragma unroll
      for (int nt = 0; nt < 8; nt++) {
        uint2 v;
        v.x = pack2(acc[mt][nt][0], acc[mt][nt][1]);
        v.y = pack2(acc[mt][nt][2], acc[mt][nt][3]);
        *(uint2*)(dst + (size_t)(nt * 16 + r16) * S_ + rbase + mt * 16) = v;
      }
  } else if (nti == 14) {
    float* dst = (float*)(ws + OFF_GATES);
#pragma unroll
    for (int mt = 0; mt < 2; mt++)
#pragma unroll
      for (int nt = 0; nt < 3; nt++)
#pragma unroll
        for (int i = 0; i < 4; i++) dst[(size_t)(rbase + mt * 16 + i) * 48 + nt * 16 + r16] = sigmoidf_(acc[mt][nt][i]);
  } else if (nti <= 18) {
    u16* dst = (u16*)(ws + OFF_QR);
    const int hd = nti - 15;
#pragma unroll
    for (int mt = 0; mt < 2; mt++)
#pragma unroll
      for (int nt = 0; nt < 8; nt++)
#pragma unroll
        for (int i = 0; i < 4; i++) dst[(size_t)(rbase + mt * 16 + i) * 512 + hd * 128 + nt * 16 + r16] = f2bf(acc[mt][nt][i]);
  } else if (nti <= 22) {
    u16* dst = (u16*)(ws + OFF_KR);
    u16* dstT = (u16*)(ws + OFF_KRTD);
    const int hd = nti - 19;
    const float logg = logg_of(hd);
#pragma unroll
    for (int mt = 0; mt < 2; mt++) {
      float dk[4];
#pragma unroll
      for (int i = 0; i < 4; i++) dk[i] = __expf(logg * (float)(127 - ((rbase + mt * 16 + i) & 127)));
#pragma unroll
      for (int nt = 0; nt < 8; nt++) {
#pragma unroll
        for (int i = 0; i < 4; i++) dst[(size_t)(rbase + mt * 16 + i) * 512 + hd * 128 + nt * 16 + r16] = f2bf(acc[mt][nt][i]);
        uint2 v;
        v.x = pack2(acc[mt][nt][0] * dk[0], acc[mt][nt][1] * dk[1]);
        v.y = pack2(acc[mt][nt][2] * dk[2], acc[mt][nt][3] * dk[3]);
        *(uint2*)(dstT + (size_t)(hd * 128 + nt * 16 + r16) * S_ + rbase + mt * 16) = v;
      }
    }
  } else {
    u16* dstT = (u16*)(ws + OFF_VRT);
    const int cb = (nti - 23) * 128;
#pragma unroll
    for (int mt = 0; mt < 2; mt++)
#pragma unroll
      for (int nt = 0; nt < 8; nt++) {
        uint2 v;
        v.x = pack2(acc[mt][nt][0], acc[mt][nt][1]);
        v.y = pack2(acc[mt][nt][2], acc[mt][nt][3]);
        *(uint2*)(dstT + (size_t)(cb + nt * 16 + r16) * S_ + rbase + mt * 16) = v;
      }
  }
}

__device__ __forceinline__ void phase1(const Params& p, char* smem) {
  u16* sA = (u16*)smem;
  u16* sB = sA + 128 * LDT;
  const u16* hh = (const u16*)(p.ws + OFF_HH);
  const u16* hl = (const u16*)(p.ws + OFF_HL);
  const u16* w1 = (const u16*)((char*)p.out + OO_W1T);
  const u16* w1lo = (const u16*)(p.ws + OFF_W1LO);
  for (int it = 0;; it++) {
    int mtile, nti; bool valid;
    if (!next_tile(it, 128, 31, 8, 8, mtile, nti, valid)) break;
    if (!valid) continue;
    const int m0 = mtile * 128, n0 = nti * 128;
    f32x4 acc[2][8];
    zero_acc(acc);
    if (nti < 9) gemm_acc<true>(acc, hl + (size_t)m0 * 1024, 1024, w1lo + (size_t)n0 * 1024, 1024, 1024, sA, sB);
    else gemm_acc(acc, hh + (size_t)m0 * 1024, 1024, w1 + (size_t)n0 * 1024, 1024, 1024, sA, sB);
    p1_epilogue(p, nti, m0, acc);
  }
}

__device__ __forceinline__ void phase2(const Params& p, char* smem) {
  float* tile = (float*)smem;
  float* posl = tile + 144 * 64;
  float* red = tile;
  float* hid = posl + 32 * 64;
  const int tid = otid();
  char* oo = (char*)p.out;
  for (int task = obid(); task < 512; task += gridDim.x) {
    const int which = task >> 8, head = (task >> 7) & 1, g = task & 127;
    const float* src = (const float*)(oo + (which ? OO_VC : OO_KC));
    const float* pos = which ? p.cpv : p.cpk;
    const float* w1 = which ? p.cw1v : p.cw1k;
    const float* w2 = which ? p.cw2v : p.cw2k;
    __syncthreads();
#pragma unroll
    for (int i = 0; i < 9; i++) {
      int id = tid + 256 * i, tk = id >> 4, c4 = id & 15, tok = 128 * g + tk;
      float4 v = float4{0.f, 0.f, 0.f, 0.f};
      if (tok < S_) v = *(const float4*)(src + (size_t)tok * 128 + head * 64 + c4 * 4);
      ((float4*)tile)[tk * 16 + c4] = v;
    }
#pragma unroll
    for (int i = 0; i < 2; i++) ((float4*)posl)[tid + 256 * i] = ((const float4*)pos)[tid + 256 * i];
    __syncthreads();
    const int j4 = tid & 31, kp = tid >> 5;
    float acc[9][4];
#pragma unroll
    for (int r = 0; r < 9; r++)
#pragma unroll
      for (int cc = 0; cc < 4; cc++) acc[r][cc] = 0.f;
    for (int l = kp * 4; l < kp * 4 + 4; l++) {
#pragma unroll 2
      for (int d4 = 0; d4 < 16; d4++) {
        const int kk = l * 64 + d4 * 4;
        float4 wv[4];
#pragma unroll
        for (int q = 0; q < 4; q++) wv[q] = *(const float4*)(w1 + (size_t)(kk + q) * 128 + j4 * 4);
#pragma unroll
        for (int r = 0; r < 9; r++) {
          const float4 xv = (r < 8) ? ((const float4*)tile)[(16 * r + l) * 16 + d4] : ((const float4*)posl)[l * 16 + d4];
          acc[r][0] += xv.x * wv[0].x + xv.y * wv[1].x + xv.z * wv[2].x + xv.w * wv[3].x;
          acc[r][1] += xv.x * wv[0].y + xv.y * wv[1].y + xv.z * wv[2].y + xv.w * wv[3].y;
          acc[r][2] += xv.x * wv[0].z + xv.y * wv[1].z + xv.z * wv[2].z + xv.w * wv[3].z;
          acc[r][3] += xv.x * wv[0].w + xv.y * wv[1].w + xv.z * wv[2].w + xv.w * wv[3].w;
        }
      }
    }
    __syncthreads();
#pragma unroll
    for (int r = 0; r < 9; r++) *(float4*)(red + (kp * 9 + r) * 128 + j4 * 4) = float4{acc[r][0], acc[r][1], acc[r][2], acc[r][3]};
    __syncthreads();
#pragma unroll
    for (int i = 0; i < 4; i++) {
      int id = tid + 256 * i, r = id >> 7, jj = id & 127;
      float xh = 0.f;
#pragma unroll
      for (int k = 0; k < 8; k++) xh += red[(k * 9 + r) * 128 + jj] + red[(k * 9 + 8) * 128 + jj];
      float u = 0.7978845608028654f * (xh + 0.044715f * xh * xh * xh);
      hid[r * 128 + jj] = 0.5f * xh * (2.f - 2.f / (1.f + __expf(2.f * u)));
    }
    __syncthreads();
    {
      const int r = tid >> 5, d = (tid & 31) * 2;
      float o0 = 0.f, o1 = 0.f;
      for (int jj = 0; jj < 128; jj++) {
        float hv = hid[r * 128 + jj];
        float2 wv = *(const float2*)(w2 + jj * 64 + d);
        o0 += hv * wv.x; o1 += hv * wv.y;
      }
      const int n = g * 8 + r;
      if (n == 1023) { o0 = 0.f; o1 = 0.f; }
      if (which == 0) {
        u16* kh_ = (u16*)(p.ws + OFF_KCH);
        u16* kl_ = (u16*)(p.ws + OFF_KCL);
        *(unsigned*)(kh_ + n * 128 + head * 64 + d) = packh2(o0, o1);
        (void)kl_;
      } else {
        u16* vt = (u16*)(p.ws + OFF_VCT);
        vt[(head * 64 + d) * 1024 + n] = f2bf(o0);
        vt[(head * 64 + d + 1) * 1024 + n] = f2bf(o1);
      }
    }
  }
}

__device__ __forceinline__ void phase2_ut(const Params& p, char* smem) {
  char* ws = p.ws;
  u16* sA = (u16*)smem;
  u16* sB = sA + 128 * LDT;
  const int tid = otid(), lane = tid & 63, wave = tid >> 6, quad = lane >> 4, r16 = lane & 15;
  u16* ut = (u16*)((char*)p.out + OO_UT);
  for (int task = obid(); task < 1024; task += gridDim.x) {
    const int cch = task >> 3, hd = (task >> 1) & 3, dvt = task & 1;
    const u16* vrt = (const u16*)(ws + OFF_VRT) + (size_t)(hd * 256 + dvt * 128) * S_ + cch * 128;
    const u16* krt = (const u16*)(ws + OFF_KRTD) + (size_t)(hd * 128) * S_ + cch * 128;
    f32x4 acc[2][8];
    zero_acc(acc);
    gemm_acc(acc, vrt, S_, krt, S_, 128, sA, sB);
    u16* dst = ut + ((size_t)(cch * 4 + hd) * 256 + dvt * 128) * 128;
#pragma unroll
    for (int mt = 0; mt < 2; mt++)
#pragma unroll
      for (int nt = 0; nt < 8; nt++)
#pragma unroll
        for (int i = 0; i < 4; i++) dst[(wave * 32 + mt * 16 + quad * 4 + i) * 128 + nt * 16 + r16] = f2bf(acc[mt][nt][i]);
  }
}

#define P3_KH 0
#define P3_KL 9216
#define P3_V 18432
#define P3_IMP 27648
#define P3_SEL (27648 + 4 * NG * 2 * 1040)
#define P3_SELN (P3_SEL + 4 * NG * 2 * 64)
#define P3_TASK (P3_SELN + 128)
#define P3T 72
#define NG 2

template <int CTRL>
__device__ __forceinline__ float dpp_f(float a) { return __int_as_float(__builtin_amdgcn_mov_dpp(__float_as_int(a), CTRL, 0xf, 0xf, true)); }
__device__ __forceinline__ float hsum8(float a) {
  a += dpp_f<0xB1>(a);
  a += dpp_f<0x4E>(a);
  a += dpp_f<0x141>(a);
  return a;
}

__device__ __forceinline__ void softmax_pv(f32x4 (&s)[4], int kbase, bool colactive, int tq, int W, const bf16x8 (&vf)[2][4], f32x4 (&o)[4],
                                           float& m_run, float& l_run, int quad) {
  float mx = NEGF;
  bool ok[4][4];
#pragma unroll
  for (int a = 0; a < 4; a++)
#pragma unroll
    for (int i = 0; i < 4; i++) {
      int kpos = kbase + 16 * a + 4 * quad + i;
      ok[a][i] = colactive && (kpos <= tq) && (kpos > tq - W);
      s[a][i] *= 0.125f;
      if (ok[a][i]) mx = fmaxf(mx, s[a][i]);
    }
  mx = fmaxf(mx, __shfl_xor(mx, 16));
  mx = fmaxf(mx, __shfl_xor(mx, 32));
  const float m_new = fmaxf(m_run, mx);
  const float alpha = __expf(m_run - m_new);
  m_run = m_new;
  float ps = 0.f;
#pragma unroll
  for (int a = 0; a < 4; a++)
#pragma unroll
    for (int i = 0; i < 4; i++) {
      float pv = ok[a][i] ? __expf(s[a][i] - m_new) : 0.f;
      s[a][i] = pv;
      ps += pv;
    }
  l_run = l_run * alpha + ps;
#pragma unroll
  for (int dt = 0; dt < 4; dt++)
#pragma unroll
    for (int i = 0; i < 4; i++) o[dt][i] *= alpha;
#pragma unroll
  for (int kk = 0; kk < 2; kk++) {
    union { bf16x8 v; unsigned u[4]; } pf;
    pf.u[0] = pack2(s[2 * kk][0], s[2 * kk][1]);
    pf.u[1] = pack2(s[2 * kk][2], s[2 * kk][3]);
    pf.u[2] = pack2(s[2 * kk + 1][0], s[2 * kk + 1][1]);
    pf.u[3] = pack2(s[2 * kk + 1][2], s[2 * kk + 1][3]);
#pragma unroll
    for (int dt = 0; dt < 4; dt++) o[dt] = __builtin_amdgcn_mfma_f32_16x16x32_bf16(vf[kk][dt], pf.v, o[dt], 0, 0, 0);
  }
}

__device__ __forceinline__ void attn_tile_task(const Params& p, int qt, int kvh, char* smem) {
  char* ws = p.ws;
  const int tid = otid(), lane = tid & 63, wave = tid >> 6, quad = lane >> 4, c = lane & 15, qsel = c >> 3, h = c & 7;
  const int t0 = qt * (8 * NG), tw = t0 + wave * (2 * NG), H = kvh * 8 + h;
  u16* sKh = (u16*)(smem + P3_KH);
  u16* sKl = (u16*)(smem + P3_KL);
  u16* sV = (u16*)(smem + P3_V);
  volatile float* imp = (volatile float*)(smem + P3_IMP + wave * (NG * 2 * 1040));
  volatile int* sel = (volatile int*)(smem + P3_SEL + wave * (NG * 2 * 64));
  volatile int* seln = (volatile int*)(smem + P3_SELN + wave * 32);
  const u16* q_hi = (const u16*)(ws + OFF_QHI);
  const u16* q_lo = (const u16*)(ws + OFF_QLO);
  u16* part = (u16*)(ws + OFF_QLO);
  const float* gates = (const float*)(ws + OFF_GATES);
  const int lr = tid >> 3, lcc = (tid & 7) * 8;

#ifndef CMPREP
#define CMPREP 1
#endif
#pragma unroll 1
  for (int rep = 0; rep < CMPREP; rep++) {
    bf16x8 ql[NG][2];
    int nmaxq[NG];
#pragma unroll
    for (int g = 0; g < NG; g++) {
      const int tq = tw + 2 * g + qsel;
      nmaxq[g] = (tq - 31) >> 4;
#pragma unroll
      for (int ks = 0; ks < 2; ks++) {
        ql[g][ks] = *(const bf16x8*)(q_lo + (size_t)tq * 1024 + H * 64 + ks * 32 + quad * 8);
      }
    }
    const int nmaxt = (t0 + 8 * NG - 32) >> 4;
    const int NCH = nmaxt >= 0 ? (nmaxt >> 6) + 1 : 0;
    const u16* kch = (const u16*)(ws + OFF_KCH) + kvh * 64;
    const u16* kcl = (const u16*)(ws + OFF_KCL) + kvh * 64;
    const u16* vct = (const u16*)(ws + OFF_VCT) + (size_t)(kvh * 64) * 1024;
    float m_l[NG], l_l[NG];
#pragma unroll
    for (int g = 0; g < NG; g++) { m_l[g] = NEGF; l_l[g] = 0.f; }
    u32x4 pk[4], pv[2];
#pragma unroll
    for (int i = 0; i < 2; i++) {
      pk[i] = *(const u32x4*)(kch + (size_t)(lr + 32 * i) * 128 + lcc);
    }
    for (int ch = 0; ch < NCH; ch++) {
      __syncthreads();
#pragma unroll
      for (int i = 0; i < 2; i++) {
        *(u32x4*)(sKh + (lr + 32 * i) * P3T + lcc) = pk[i];
      }
      __syncthreads();
      if (ch + 1 < NCH) {
#pragma unroll
        for (int i = 0; i < 2; i++) {
          pk[i] = *(const u32x4*)(kch + (size_t)(64 * (ch + 1) + lr + 32 * i) * 128 + lcc);
        }
      }
#pragma unroll
      for (int a = 0; a < 4; a++) {
        bf16x8 kh_[2];
#pragma unroll
        for (int ks = 0; ks < 2; ks++) {
          kh_[ks] = *(const bf16x8*)(sKh + (16 * a + c) * P3T + ks * 32 + quad * 8);
        }
        const int nb = 64 * ch + 16 * a + 4 * quad;
#pragma unroll
        for (int g = 0; g < NG; g++) {
          f32x4 s = f32x4{0.f, 0.f, 0.f, 0.f};
#pragma unroll
          for (int ks = 0; ks < 2; ks++) {
            s = mfma16(kh_[ks], ql[g][ks], s);
          }
          float mx = NEGF;
#pragma unroll
          for (int i = 0; i < 4; i++) {
            s[i] *= 0.125f;
            if (nb + i <= nmaxq[g]) mx = fmaxf(mx, s[i]);
          }
          const float m_new = fmaxf(m_l[g], mx);
          float ll = l_l[g] * __expf(m_l[g] - m_new);
#pragma unroll
          for (int i = 0; i < 4; i++)
            if (nb + i <= nmaxq[g]) ll += __expf(s[i] - m_new);
          l_l[g] = ll;
          m_l[g] = m_new;
        }
      }
    }
    float Mx[NG], invL[NG];
#pragma unroll
    for (int g = 0; g < NG; g++) {
      float M = fmaxf(m_l[g], __shfl_xor(m_l[g], 16));
      M = fmaxf(M, __shfl_xor(M, 32));
      float ll = l_l[g] * __expf(m_l[g] - M);
      ll += __shfl_xor(ll, 16);
      ll += __shfl_xor(ll, 32);
      Mx[g] = M;
      invL[g] = (ll > 0.f) ? 1.f / ll : 0.f;
    }
    f32x4 ocmp[NG][4];
    float carry[NG];
#pragma unroll
    for (int g = 0; g < NG; g++) {
      carry[g] = 0.f;
#pragma unroll
      for (int dt = 0; dt < 4; dt++) ocmp[g][dt] = f32x4{0.f, 0.f, 0.f, 0.f};
    }
#pragma unroll
    for (int i = 0; i < 2; i++) {
      pk[i] = *(const u32x4*)(kch + (size_t)(lr + 32 * i) * 128 + lcc);
      pv[i] = *(const u32x4*)(vct + (size_t)(lr + 32 * i) * 1024 + lcc);
    }
    for (int ch = 0; ch < NCH; ch++) {
      __syncthreads();
#pragma unroll
      for (int i = 0; i < 2; i++) {
        *(u32x4*)(sKh + (lr + 32 * i) * P3T + lcc) = pk[i];
        *(u32x4*)(sV + (lr + 32 * i) * P3T + lcc) = pv[i];
      }
      __syncthreads();
      if (ch + 1 < NCH) {
#pragma unroll
        for (int i = 0; i < 2; i++) {
          pk[i] = *(const u32x4*)(kch + (size_t)(64 * (ch + 1) + lr + 32 * i) * 128 + lcc);
          pv[i] = *(const u32x4*)(vct + (size_t)(lr + 32 * i) * 1024 + 64 * (ch + 1) + lcc);
        }
      }
#pragma unroll
      for (int kk = 0; kk < 2; kk++) {
        float pr[NG][2][4];
#pragma unroll
        for (int e = 0; e < 2; e++) {
          const int a = 2 * kk + e;
          bf16x8 kh_[2];
#pragma unroll
          for (int ks = 0; ks < 2; ks++) {
            kh_[ks] = *(const bf16x8*)(sKh + (16 * a + c) * P3T + ks * 32 + quad * 8);
          }
          const int nb = 64 * ch + 16 * a + 4 * quad;
#pragma unroll
          for (int g = 0; g < NG; g++) {
            f32x4 s = f32x4{0.f, 0.f, 0.f, 0.f};
#pragma unroll
            for (int ks = 0; ks < 2; ks++) {
              s = mfma16(kh_[ks], ql[g][ks], s);
            }
#pragma unroll
            for (int i = 0; i < 4; i++) pr[g][e][i] = (nb + i <= nmaxq[g]) ? __expf(s[i] * 0.125f - Mx[g]) * invL[g] : 0.f;
            float av = hsum8(pr[g][e][0] + pr[g][e][1] + pr[g][e][2] + 0.5f * pr[g][e][3]);
            float bv = hsum8(0.5f * pr[g][e][3]);
            const float bs = __shfl(bv, (lane + 48) & 63);
            av += (quad > 0) ? bs : carry[g];
            carry[g] = bs;
            if (h == 0) imp[(2 * g + qsel) * 260 + 16 * ch + 4 * a + quad] = av;
          }
        }
        bf16x8 vf[4];
#pragma unroll
        for (int dt = 0; dt < 4; dt++) {
          union { bf16x8 v; u32x2 u[2]; } t;
          t.u[0] = *(const u32x2*)(sV + (dt * 16 + c) * P3T + 32 * kk + 4 * quad);
          t.u[1] = *(const u32x2*)(sV + (dt * 16 + c) * P3T + 32 * kk + 16 + 4 * quad);
          vf[dt] = t.v;
        }
#pragma unroll
        for (int g = 0; g < NG; g++) {
          union { bf16x8 v; unsigned u[4]; } pf;
          pf.u[0] = pack2(pr[g][0][0], pr[g][0][1]);
          pf.u[1] = pack2(pr[g][0][2], pr[g][0][3]);
          pf.u[2] = pack2(pr[g][1][0], pr[g][1][1]);
          pf.u[3] = pack2(pr[g][1][2], pr[g][1][3]);
#pragma unroll
          for (int dt = 0; dt < 4; dt++) ocmp[g][dt] = __builtin_amdgcn_mfma_f32_16x16x32_bf16(vf[dt], pf.v, ocmp[g][dt], 0, 0, 0);
        }
      }
    }
#pragma unroll
    for (int g = 0; g < NG; g++) {
      const int tq = tw + 2 * g + qsel;
      const float g0 = gates[(size_t)tq * 48 + H * 3 + 0];
#pragma unroll
      for (int dt = 0; dt < 4; dt++) {
        u32x2 v;
        v.x = pack2(g0 * ocmp[g][dt][0], g0 * ocmp[g][dt][1]);
        v.y = pack2(g0 * ocmp[g][dt][2], g0 * ocmp[g][dt][3]);
        *(u32x2*)(part + (size_t)tq * 1024 + H * 64 + dt * 16 + 4 * quad) = v;
      }
    }
  }

#ifndef WINREP
#define WINREP 1
#endif
#pragma unroll 1
  for (int wrep = 0; wrep < WINREP; wrep++) {
    bf16x8 qh[NG][2];
    int tqs[NG];
#pragma unroll
    for (int g = 0; g < NG; g++) {
      tqs[g] = tw + 2 * g + qsel;
#pragma unroll
      for (int ks = 0; ks < 2; ks++) qh[g][ks] = *(const bf16x8*)(q_hi + (size_t)tqs[g] * 1024 + H * 64 + ks * 32 + quad * 8);
    }
    f32x4 ow[NG][4];
    float mw[NG], lw[NG];
#pragma unroll
    for (int g = 0; g < NG; g++) {
      mw[g] = NEGF; lw[g] = 0.f;
#pragma unroll
      for (int dt = 0; dt < 4; dt++) ow[g][dt] = f32x4{0.f, 0.f, 0.f, 0.f};
    }
    const u16* kwb = (const u16*)(ws + OFF_KW) + kvh * 64;
    const u16* vwt = (const u16*)(ws + OFF_VWT) + (size_t)(kvh * 64) * S_;
    int lo = t0 - 511; if (lo < 0) lo = 0;
    const int jlo = lo >> 6, jhi = (t0 + 8 * NG - 1) >> 6;
    u32x4 pk[2], pv[2];
#pragma unroll
    for (int i = 0; i < 2; i++) {
      pk[i] = *(const u32x4*)(kwb + (size_t)(64 * jlo + lr + 32 * i) * 128 + lcc);
      pv[i] = *(const u32x4*)(vwt + (size_t)(lr + 32 * i) * S_ + 64 * jlo + lcc);
    }
    for (int j = jlo; j <= jhi; j++) {
      __syncthreads();
#pragma unroll
      for (int i = 0; i < 2; i++) {
        *(u32x4*)(sKh + (lr + 32 * i) * P3T + lcc) = pk[i];
        *(u32x4*)(sV + (lr + 32 * i) * P3T + lcc) = pv[i];
      }
      __syncthreads();
      if (j + 1 <= jhi) {
#pragma unroll
        for (int i = 0; i < 2; i++) {
          pk[i] = *(const u32x4*)(kwb + (size_t)(64 * (j + 1) + lr + 32 * i) * 128 + lcc);
          pv[i] = *(const u32x4*)(vwt + (size_t)(lr + 32 * i) * S_ + 64 * (j + 1) + lcc);
        }
      }
      bf16x8 kf[4][2], vf[2][4];
#pragma unroll
      for (int a = 0; a < 4; a++)
#pragma unroll
        for (int ks = 0; ks < 2; ks++) kf[a][ks] = *(const bf16x8*)(sKh + (16 * a + c) * P3T + ks * 32 + quad * 8);
#pragma unroll
      for (int kk = 0; kk < 2; kk++)
#pragma unroll
        for (int dt = 0; dt < 4; dt++) {
          union { bf16x8 v; u32x2 u[2]; } t;
          t.u[0] = *(const u32x2*)(sV + (dt * 16 + c) * P3T + 32 * kk + 4 * quad);
          t.u[1] = *(const u32x2*)(sV + (dt * 16 + c) * P3T + 32 * kk + 16 + 4 * quad);
          vf[kk][dt] = t.v;
        }
#pragma unroll
      for (int g = 0; g < NG; g++) {
        f32x4 s[4];
#pragma unroll
        for (int a = 0; a < 4; a++) {
          s[a] = f32x4{0.f, 0.f, 0.f, 0.f};
#pragma unroll
          for (int ks = 0; ks < 2; ks++) s[a] = __builtin_amdgcn_mfma_f32_16x16x32_bf16(kf[a][ks], qh[g][ks], s[a], 0, 0, 0);
        }
        softmax_pv(s, 64 * j, true, tqs[g], 512, vf, ow[g], mw[g], lw[g], quad);
      }
    }
#pragma unroll
    for (int g = 0; g < NG; g++) {
      float L = lw[g] + __shfl_xor(lw[g], 16);
      L += __shfl_xor(L, 32);
      const float g2 = gates[(size_t)tqs[g] * 48 + H * 3 + 2] / fmaxf(L, 1e-30f);
#pragma unroll
      for (int dt = 0; dt < 4; dt++) {
        u16* pp = part + (size_t)tqs[g] * 1024 + H * 64 + dt * 16 + 4 * quad;
        u32x2 v = *(const u32x2*)pp;
        float y0 = __uint_as_float(v.x << 16) + g2 * ow[g][dt][0];
        float y1 = __uint_as_float(v.x & 0xffff0000u) + g2 * ow[g][dt][1];
        float y2 = __uint_as_float(v.y << 16) + g2 * ow[g][dt][2];
        float y3 = __uint_as_float(v.y & 0xffff0000u) + g2 * ow[g][dt][3];
        v.x = pack2(y0, y1); v.y = pack2(y2, y3);
        if (wrep == WINREP - 1 || L == 12345.678f) *(u32x2*)pp = v;
      }
    }
  }

#ifndef TOPKREP
#define TOPKREP 1
#endif
#pragma unroll 1
  for (int trep = 0; trep < TOPKREP; trep++) {
    const unsigned long long lt = (1ull << lane) - 1ull;
    unsigned bitsq[2 * NG][4], thq[2 * NG];
    int Rq[2 * NG];
    bool srch[2 * NG], act[2 * NG];
#pragma unroll
    for (int qi = 0; qi < 2 * NG; qi++) {
      const int cur = (tw + qi) >> 6;
#pragma unroll
      for (int e = 0; e < 4; e++) {
        const int jj = lane + 64 * e;
        const bool forced = (jj == 0) || (jj == cur) || (jj == cur - 1);
        const bool cand = (jj <= cur) && !forced;
        const float iv = imp[qi * 260 + jj];
        bitsq[qi][e] = cand ? __float_as_uint(iv) : 0u;
      }
      const int F = (cur == 0) ? 1 : ((cur == 1) ? 2 : 3);
      Rq[qi] = 16 - F;
      srch[qi] = (cur + 1 - F) > Rq[qi];
      act[qi] = srch[qi];
      thq[qi] = 0u;
    }
    for (int bit = 30; bit >= 0; bit--) {
      bool any = false;
#pragma unroll
      for (int qi = 0; qi < 2 * NG; qi++) {
        if (act[qi]) {
          const unsigned t2 = thq[qi] | (1u << bit);
          int cnt = 0;
#pragma unroll
          for (int e = 0; e < 4; e++) cnt += __popcll(__ballot(bitsq[qi][e] >= t2));
          if (cnt >= Rq[qi]) {
            thq[qi] = t2;
            if (cnt == Rq[qi]) act[qi] = false;
          }
        }
        any = any || act[qi];
      }
      if (!any) break;
    }
#pragma unroll
    for (int qi = 0; qi < 2 * NG; qi++) {
      const int cur = (tw + qi) >> 6;
      bool forced[4], cand[4], selv[4];
#pragma unroll
      for (int e = 0; e < 4; e++) {
        const int jj = lane + 64 * e;
        forced[e] = (jj == 0) || (jj == cur) || (jj == cur - 1);
        cand[e] = (jj <= cur) && !forced[e];
      }
      if (!srch[qi]) {
#pragma unroll
        for (int e = 0; e < 4; e++) selv[e] = forced[e] || cand[e];
      } else {
        const unsigned th = thq[qi];
        int cgt = 0;
#pragma unroll
        for (int e = 0; e < 4; e++) cgt += __popcll(__ballot(cand[e] && bitsq[qi][e] > th));
        const int need = Rq[qi] - cgt;
        int prior = 0;
#pragma unroll
        for (int e = 0; e < 4; e++) {
          const bool eq = cand[e] && bitsq[qi][e] == th;
          const unsigned long long m = __ballot(eq);
          const int rank = prior + __popcll(m & lt);
          selv[e] = forced[e] || (cand[e] && bitsq[qi][e] > th) || (eq && rank < need);
          prior += __popcll(m);
        }
      }
      if (qi & 1) {
#pragma unroll
        for (int e = 0; e < 4; e++) selv[e] = selv[e] && !forced[e];
      }
      int base = 0;
#pragma unroll
      for (int e = 0; e < 4; e++) {
        const unsigned long long m = __ballot(selv[e]);
        if (selv[e]) sel[qi * 16 + base + __popcll(m & lt)] = lane + 64 * e;
        base += __popcll(m);
      }
      if (lane == 0) seln[qi] = base;
    }
  }
  __builtin_amdgcn_wave_barrier();

  {
    const u16* ksb = (const u16*)(ws + OFF_KS) + (size_t)kvh * 256 * 4096 + lane * 8;
    const u16* vst = (const u16*)(ws + OFF_VST) + (size_t)kvh * 256 * 4096 + lane * 8;
    u16* ya = (u16*)(ws + OFF_QHI);
    const int curb = tw >> 6;
    bf16x8 qh[NG][2];
    f32x4 os[NG][4];
    float ms[NG], ls[NG];
    int tqs[NG], n0[NG], ntot[NG];
    u32x4 kn[NG][4][2], vn[NG][2][4];
    int jn[NG];
    int nmax = 0;
#pragma unroll
    for (int g = 0; g < NG; g++) {
      tqs[g] = tw + 2 * g + qsel;
      ms[g] = NEGF; ls[g] = 0.f;
#pragma unroll
      for (int ks = 0; ks < 2; ks++) qh[g][ks] = *(const bf16x8*)(q_hi + (size_t)tqs[g] * 1024 + H * 64 + ks * 32 + quad * 8);
#pragma unroll
      for (int dt = 0; dt < 4; dt++) os[g][dt] = f32x4{0.f, 0.f, 0.f, 0.f};
      n0[g] = __builtin_amdgcn_readfirstlane(seln[2 * g]);
      ntot[g] = n0[g] + __builtin_amdgcn_readfirstlane(seln[2 * g + 1]);
      nmax = ntot[g] > nmax ? ntot[g] : nmax;
      jn[g] = __builtin_amdgcn_readfirstlane(sel[(2 * g) * 16]);
      const u16* kp = ksb + (size_t)jn[g] * 4096;
      const u16* vp = vst + (size_t)jn[g] * 4096;
#pragma unroll
      for (int a = 0; a < 4; a++)
#pragma unroll
        for (int ks = 0; ks < 2; ks++) kn[g][a][ks] = *(const u32x4*)(kp + (a * 2 + ks) * 512);
#pragma unroll
      for (int kk = 0; kk < 2; kk++)
#pragma unroll
        for (int dt = 0; dt < 4; dt++) vn[g][kk][dt] = *(const u32x4*)(vp + (kk * 4 + dt) * 512);
    }
    for (int idx = 0; idx < nmax; idx++) {
#pragma unroll
      for (int g = 0; g < NG; g++) {
        const int jthis = jn[g];
        const bool valid = idx < ntot[g];
        const int qs = (idx < n0[g]) ? 0 : 1;
        f32x4 sc[4];
        bf16x8 vf[2][4];
#pragma unroll
        for (int a = 0; a < 4; a++) {
          sc[a] = f32x4{0.f, 0.f, 0.f, 0.f};
#pragma unroll
          for (int ks = 0; ks < 2; ks++) {
            union { bf16x8 v; u32x4 u; } t; t.u = kn[g][a][ks];
            sc[a] = __builtin_amdgcn_mfma_f32_16x16x32_bf16(t.v, qh[g][ks], sc[a], 0, 0, 0);
          }
        }
#pragma unroll
        for (int kk = 0; kk < 2; kk++)
#pragma unroll
          for (int dt = 0; dt < 4; dt++) { union { bf16x8 v; u32x4 u; } t; t.u = vn[g][kk][dt]; vf[kk][dt] = t.v; }
        const bool forced_blk = (jthis == 0) || (jthis == curb) || (jthis == curb - 1);
        softmax_pv(sc, 64 * jthis, valid && (forced_blk || (qsel == qs)), tqs[g], 1 << 30, vf, os[g], ms[g], ls[g], quad);
        int nx = idx + 1;
        nx = nx < ntot[g] ? nx : ntot[g] - 1;
        const int j = __builtin_amdgcn_readfirstlane((nx < n0[g]) ? sel[(2 * g) * 16 + nx] : sel[(2 * g + 1) * 16 + (nx - n0[g])]);
        jn[g] = j;
        const u16* kp = ksb + (size_t)j * 4096;
        const u16* vp = vst + (size_t)j * 4096;
#pragma unroll
        for (int a = 0; a < 4; a++)
#pragma unroll
          for (int ks = 0; ks < 2; ks++) kn[g][a][ks] = *(const u32x4*)(kp + (a * 2 + ks) * 512);
#pragma unroll
        for (int kk = 0; kk < 2; kk++)
#pragma unroll
          for (int dt = 0; dt < 4; dt++) vn[g][kk][dt] = *(const u32x4*)(vp + (kk * 4 + dt) * 512);
      }
    }
#pragma unroll
    for (int g = 0; g < NG; g++) {
      float L = ls[g] + __shfl_xor(ls[g], 16);
      L += __shfl_xor(L, 32);
      const float g1 = gates[(size_t)tqs[g] * 48 + H * 3 + 1] / fmaxf(L, 1e-30f);
#pragma unroll
      for (int dt = 0; dt < 4; dt++) {
        const u32x2 v = *(const u32x2*)(part + (size_t)tqs[g] * 1024 + H * 64 + dt * 16 + 4 * quad);
        float y0 = __uint_as_float(v.x << 16) + g1 * os[g][dt][0];
        float y1 = __uint_as_float(v.x & 0xffff0000u) + g1 * os[g][dt][1];
        float y2 = __uint_as_float(v.y << 16) + g1 * os[g][dt][2];
        float y3 = __uint_as_float(v.y & 0xffff0000u) + g1 * os[g][dt][3];
        u32x2 o;
        o.x = pack2(y0, y1); o.y = pack2(y2, y3);
        *(u32x2*)(ya + (size_t)tqs[g] * 1024 + H * 64 + dt * 16 + 4 * quad) = o;
      }
    }
  }
}

__device__ __forceinline__ void gr_tile(const Params& p, int t, char* smem) {
  char* ws = p.ws;
  const int tid = otid(), lane = tid & 63, wave = tid >> 6, quad = lane >> 4, r16 = lane & 15;
  const int m0 = (t >> 3) * 128, nti = t & 7;
  const u16* hh = (const u16*)(ws + OFF_HH);
  const u16* w1 = (const u16*)((char*)p.out + OO_W1T);
  u16* dst = (u16*)(ws + OFF_G);
  f32x4 acc[2][8];
  zero_acc(acc);
  gemm_acc(acc, hh + (size_t)m0 * 1024, 1024, w1 + (size_t)(3968 + nti * 128) * 1024, 1024, 1024, (u16*)smem, nullptr);
#pragma unroll
  for (int mt = 0; mt < 2; mt++)
#pragma unroll
    for (int nt = 0; nt < 8; nt++)
#pragma unroll
      for (int i = 0; i < 4; i++)
        dst[(size_t)(m0 + wave * 32 + mt * 16 + quad * 4 + i) * 1024 + nti * 128 + nt * 16 + r16] = f2bf(siluf_(acc[mt][nt][i]));
}

__device__ __forceinline__ void phase3(const Params& p, char* smem) {
  char* ws = p.ws;
  const int tid = otid(), lane = tid & 63, wave = tid >> 6, quad = lane >> 4, r16 = lane & 15;
  const int bid = obid();
  if (bid < 64) {
    u16* ut = (u16*)((char*)p.out + OO_UT);
    u16* rtb = ut;
    const int e0 = (bid * 256 + tid) * 8;
    const float dc = __expf(logg_of(e0 >> 15) * 128.f);
    float r[8];
#pragma unroll
    for (int k = 0; k < 8; k++) r[k] = 0.f;
#pragma unroll 8
    for (int cch = 0; cch < 128; cch++) {
      const u32x4 u = *(const u32x4*)(ut + (size_t)cch * 131072 + e0);
      u32x4 o;
      o.x = pack2(r[0], r[1]); o.y = pack2(r[2], r[3]); o.z = pack2(r[4], r[5]); o.w = pack2(r[6], r[7]);
      *(u32x4*)(rtb + (size_t)cch * 131072 + e0) = o;
      r[0] = r[0] * dc + __uint_as_float(u.x << 16); r[1] = r[1] * dc + __uint_as_float(u.x & 0xffff0000u);
      r[2] = r[2] * dc + __uint_as_float(u.y << 16); r[3] = r[3] * dc + __uint_as_float(u.y & 0xffff0000u);
      r[4] = r[4] * dc + __uint_as_float(u.z << 16); r[5] = r[5] * dc + __uint_as_float(u.z & 0xffff0000u);
      r[6] = r[6] * dc + __uint_as_float(u.w << 16); r[7] = r[7] * dc + __uint_as_float(u.w & 0xffff0000u);
    }
  }
  unsigned* ctr = (unsigned*)(ws + OFF_CTR);
  volatile unsigned* stask = (volatile unsigned*)(smem + P3_TASK);
  {
  for (int pass = 0; pass < 2; pass++) {
    const int kvh = (bid & 1) ^ pass;
    while (true) {
      __syncthreads();
      if (tid == 0) *stask = atomicAdd(ctr + kvh, 1u);
      __syncthreads();
      const unsigned t = *stask;
      if (t >= (unsigned)(S_ / (8 * NG))) break;
      attn_tile_task(p, S_ / (8 * NG) - 1 - (int)t, kvh, smem);
    }
  }
  }
}

__device__ __forceinline__ void phase4(const Params& p, char* smem) {
  char* ws = p.ws;
  u16* sA = (u16*)smem;
  u16* sB = sA + 128 * LDT;
  const u16* hh = (const u16*)(ws + OFF_HH);
  const u16* w1 = (const u16*)((char*)p.out + OO_W1T);
  const u16* qr = (const u16*)(ws + OFF_QR);
  const u16* kr = (const u16*)(ws + OFF_KR);
  const u16* vrt = (const u16*)(ws + OFF_VRT);
  const u16* rtb = (const u16*)((char*)p.out + OO_UT);
  u16* pbuf = (u16*)(ws + OFF_PBUF);
  u16* yr = (u16*)(ws + OFF_YR);
  for (int task = obid(); task < 512; task += gridDim.x) {
    const int cch = task >> 2, hd = task & 3, m0 = cch * 128;
    const int tid = otid(), lane = tid & 63, wave = tid >> 6, quad = lane >> 4, r16 = lane & 15;
    const float logg = logg_of(hd);
    const int rloc = wave * 32 + quad * 4;
    const u16* gbuf = (const u16*)(ws + OFF_G);
    u16* pb = pbuf + (size_t)task * 16384;
    {
      f32x4 acc[2][8];
      zero_acc(acc);
      gemm_acc(acc, qr + (size_t)m0 * 512 + hd * 128, 512, kr + (size_t)m0 * 512 + hd * 128, 512, 128, sA, sB);
      float cf[8];
#pragma unroll
      for (int nt = 0; nt < 8; nt++) cf[nt] = __expf(-logg * (float)(nt * 16 + r16));
#pragma unroll
      for (int mt = 0; mt < 2; mt++)
#pragma unroll
        for (int i = 0; i < 4; i++) {
          const int ii = rloc + mt * 16 + i;
          const float rf = __expf(logg * (float)ii);
#pragma unroll
          for (int nt = 0; nt < 8; nt++) {
            const int jj = nt * 16 + r16;
            float v = (ii >= jj) ? acc[mt][nt][i] * rf * cf[nt] : 0.f;
            pb[ii * 128 + jj] = f2bf(v);
          }
        }
    }
    asm volatile("s_waitcnt vmcnt(0)" ::: "memory");
    __syncthreads();
    float s1[2][4], s2[2][4];
#pragma unroll
    for (int mt = 0; mt < 2; mt++)
#pragma unroll
      for (int i = 0; i < 4; i++) { s1[mt][i] = 0.f; s2[mt][i] = 0.f; }
#pragma unroll 1
    for (int dvt = 0; dvt < 2; dvt++) {
      f32x4 ao[2][8];
      zero_acc(ao);
      gemm_acc(ao, qr + (size_t)m0 * 512 + hd * 128, 512, rtb + ((size_t)(cch * 4 + hd) * 256 + dvt * 128) * 128, 128, 128, sA, sB);
#pragma unroll
      for (int mt = 0; mt < 2; mt++)
#pragma unroll
        for (int i = 0; i < 4; i++) {
          float dq = __expf(logg * (float)(rloc + mt * 16 + i + 1));
#pragma unroll
          for (int nt = 0; nt < 8; nt++) ao[mt][nt][i] *= dq;
        }
      gemm_acc(ao, pb, 128, vrt + (size_t)(hd * 256 + dvt * 128) * S_ + m0, S_, 128, sA, sB);
#pragma unroll
      for (int mt = 0; mt < 2; mt++)
#pragma unroll
        for (int i = 0; i < 4; i++)
#pragma unroll
          for (int nt = 0; nt < 8; nt++) {
            const float v = ao[mt][nt][i];
            s1[mt][i] += v; s2[mt][i] += v * v;
            yr[(size_t)(m0 + rloc + mt * 16 + i) * 1024 + hd * 256 + dvt * 128 + nt * 16 + r16] = f2bf(v);
          }
    }
#pragma unroll
    for (int mt = 0; mt < 2; mt++)
#pragma unroll
      for (int i = 0; i < 4; i++) {
        float a = s1[mt][i], b = s2[mt][i];
        a += __shfl_xor(a, 1); a += __shfl_xor(a, 2); a += __shfl_xor(a, 4); a += __shfl_xor(a, 8);
        b += __shfl_xor(b, 1); b += __shfl_xor(b, 2); b += __shfl_xor(b, 4); b += __shfl_xor(b, 8);
        const float mean = a * (1.f / 256.f);
        const float var = fmaxf(b * (1.f / 256.f) - mean * mean, 0.f);
        const float rstd = rsqrtf(var + 1e-6f);
        const size_t row = (size_t)(m0 + rloc + mt * 16 + i);
#pragma unroll
        for (int dvt = 0; dvt < 2; dvt++)
#pragma unroll
          for (int nt = 0; nt < 8; nt++) {
            const int cg = hd * 256 + dvt * 128 + nt * 16 + r16;
            const float gs = bf2f(gbuf[row * 1024 + cg]);
            u16* q = yr + row * 1024 + hd * 256 + dvt * 128 + nt * 16 + r16;
            *q = f2bf(gs * (bf2f(*q) - mean) * rstd);
          }
      }
  }
}

__device__ __forceinline__ void phase5(const Params& p, char* smem) {
  char* ws = p.ws;
  u16* sA = (u16*)smem;
  u16* sB = sA + 128 * LDT;
  const int tid = otid(), lane = tid & 63, wave = tid >> 6, quad = lane >> 4, r16 = lane & 15;
  const u16* hh = (const u16*)(ws + OFF_HH);
  const u16* w1 = (const u16*)((char*)p.out + OO_W1T);
  const u16* ya = (const u16*)(ws + OFF_QHI);
  const u16* yr = (const u16*)(ws + OFF_YR);
  const u16* wba = (const u16*)(ws + OFF_WBA);
  const u16* wbb = (const u16*)(ws + OFF_WBB);
  float* mf = (float*)(ws + OFF_MERGEDF);
  u16* mg = (u16*)(ws + OFF_MERGED);
  for (int it = 0;; it++) {
    int mtile, nti; bool valid;
    if (!next_tile(it, 128, 8, 8, 8, mtile, nti, valid)) break;
    if (!valid) continue;
    const int m0 = mtile * 128, n0 = nti * 128;
    const int rbase = m0 + wave * 32 + quad * 4;
    f32x4 acc[2][8];
    zero_acc(acc);
    gemm_acc(acc, hh + (size_t)m0 * 1024, 1024, w1 + (size_t)(6016 + n0) * 1024, 1024, 1024, sA, sB);
#pragma unroll
    for (int mt = 0; mt < 2; mt++)
#pragma unroll
      for (int nt = 0; nt < 8; nt++)
#pragma unroll
        for (int i = 0; i < 4; i++) mf[(size_t)(rbase + mt * 16 + i) * 1024 + n0 + nt * 16 + r16] = sigmoidf_(acc[mt][nt][i]);
    zero_acc(acc);
    gemm_acc(acc, yr + (size_t)m0 * 1024, 1024, wbb + (size_t)n0 * 1024, 1024, 1024, sA, sB);
#pragma unroll
    for (int mt = 0; mt < 2; mt++)
#pragma unroll
      for (int nt = 0; nt < 8; nt++)
#pragma unroll
        for (int i = 0; i < 4; i++) {
          const size_t idx = (size_t)(rbase + mt * 16 + i) * 1024 + n0 + nt * 16 + r16;
          mf[idx] = mf[idx] * acc[mt][nt][i];
        }
    zero_acc(acc);
    gemm_acc(acc, hh + (size_t)m0 * 1024, 1024, w1 + (size_t)(4992 + n0) * 1024, 1024, 1024, sA, sB);
#pragma unroll
    for (int mt = 0; mt < 2; mt++)
#pragma unroll
      for (int nt = 0; nt < 8; nt++)
#pragma unroll
        for (int i = 0; i < 4; i++) mg[(size_t)(rbase + mt * 16 + i) * 1024 + n0 + nt * 16 + r16] = f2bf(sigmoidf_(acc[mt][nt][i]));
    zero_acc(acc);
    gemm_acc(acc, ya + (size_t)m0 * 1024, 1024, wba + (size_t)n0 * 1024, 1024, 1024, sA, sB);
#pragma unroll
    for (int mt = 0; mt < 2; mt++)
#pragma unroll
      for (int nt = 0; nt < 8; nt++)
#pragma unroll
        for (int i = 0; i < 4; i++) {
          const size_t idx = (size_t)(rbase + mt * 16 + i) * 1024 + n0 + nt * 16 + r16;
          mg[idx] = f2bf(bf2f(mg[idx]) * acc[mt][nt][i] + mf[idx]);
        }
  }
}

__device__ __forceinline__ void phase_proj(const Params& p, char* smem, const u16* A, int K, const u16* Wt, float* dst, float* ssq) {
  u16* sA = (u16*)smem;
  for (int it = 0;; it++) {
    int mtile, npair; bool valid;
    if (!next_tile(it, 128, 4, 16, 4, mtile, npair, valid)) break;
    if (!valid) continue;
    const int tid = otid(), lane = tid & 63, wave = tid >> 6, quad = lane >> 4, r16 = lane & 15;
    const int m0 = mtile * 128, n0 = npair * 256;
    const int rbase = m0 + wave * 32 + quad * 4;
    f32x4 acc[2][16];
#pragma unroll
    for (int mt = 0; mt < 2; mt++)
#pragma unroll
      for (int nt = 0; nt < 16; nt++) acc[mt][nt] = f32x4{0.f, 0.f, 0.f, 0.f};
    gemm_acc_wide(acc, A + (size_t)m0 * K, K, Wt + (size_t)n0 * K, K, K, sA);
#pragma unroll
    for (int mt = 0; mt < 2; mt++)
#pragma unroll
      for (int i = 0; i < 4; i++) {
        float sq = 0.f;
#pragma unroll
        for (int nt = 0; nt < 16; nt++) {
          float v = acc[mt][nt][i];
          dst[(size_t)(rbase + mt * 16 + i) * 1024 + n0 + nt * 16 + r16] = v;
          sq += v * v;
        }
        sq += __shfl_xor(sq, 1); sq += __shfl_xor(sq, 2); sq += __shfl_xor(sq, 4); sq += __shfl_xor(sq, 8);
        if (r16 == 0) { ssq[(size_t)(rbase + mt * 16 + i) * 8 + 2 * npair] = sq; ssq[(size_t)(rbase + mt * 16 + i) * 8 + 2 * npair + 1] = 0.f; }
      }
  }
}

__device__ __forceinline__ void phase7(const Params& p) {
  char* ws = p.ws;
  const int lane = otid() & 63, wave = otid() >> 6;
  const int gw = obid() * 4 + wave, nw = gridDim.x * 4;
  const float* mix = (const float*)(ws + OFF_MIX);
  const float* ssq = (const float*)(ws + OFF_SSQ1);
  u16* h2 = (u16*)(ws + OFF_H2);
  for (int row0 = gw * 4; row0 < S_; row0 += nw * 4) {
    f32x4 xv[4][4], mv[4][4], g[4];
    float rs[4], s2[4];
#pragma unroll
    for (int r = 0; r < 4; r++)
#pragma unroll
      for (int i = 0; i < 4; i++) {
        xv[r][i] = ((const f32x4*)(p.x + (size_t)(row0 + r) * 1024))[lane + 64 * i];
        mv[r][i] = ((const f32x4*)(mix + (size_t)(row0 + r) * 1024))[lane + 64 * i];
      }
#pragma unroll
    for (int i = 0; i < 4; i++) g[i] = ((const f32x4*)p.g_post_mix)[lane + 64 * i];
#pragma unroll
    for (int r = 0; r < 4; r++) {
      float ss = 0.f;
#pragma unroll
      for (int i = 0; i < 8; i++) ss += ssq[(size_t)(row0 + r) * 8 + i];
      rs[r] = rsqrtf(ss * (1.f / 1024.f) + 1e-6f);
    }
#pragma unroll
    for (int r = 0; r < 4; r++) {
      s2[r] = 0.f;
#pragma unroll
      for (int i = 0; i < 4; i++) {
        f32x4 v = xv[r][i] + mv[r][i] * g[i] * rs[r];
        xv[r][i] = v;
        s2[r] += v[0] * v[0] + v[1] * v[1] + v[2] * v[2] + v[3] * v[3];
        ((f32x4*)(p.out + (size_t)(row0 + r) * 1024))[lane + 64 * i] = v;
      }
    }
#pragma unroll
    for (int o = 32; o >= 1; o >>= 1)
#pragma unroll
      for (int r = 0; r < 4; r++) s2[r] += __shfl_xor(s2[r], o);
#pragma unroll
    for (int i = 0; i < 4; i++) g[i] = ((const f32x4*)p.g_pre_ffn)[lane + 64 * i];
#pragma unroll
    for (int r = 0; r < 4; r++) {
      const float rs2 = rsqrtf(s2[r] * (1.f / 1024.f) + 1e-6f);
#pragma unroll
      for (int i = 0; i < 4; i++) {
        const f32x4 v = xv[r][i] * g[i] * rs2;
        u32x2 H;
        H.x = pack2(v[0], v[1]); H.y = pack2(v[2], v[3]);
        *(u32x2*)(h2 + (size_t)(row0 + r) * 1024 + (lane + 64 * i) * 4) = H;
      }
    }
  }
}

__device__ __forceinline__ void phase8(const Params& p, char* smem) {
  char* ws = p.ws;
  u16* sA = (u16*)smem;
  u16* sB = sA + 128 * LDT;
  const int tid = otid(), lane = tid & 63, wave = tid >> 6, quad = lane >> 4, r16 = lane & 15;
  const u16* h2 = (const u16*)(ws + OFF_H2);
  const u16* wgu = (const u16*)(ws + OFF_WGU);
  u16* act = (u16*)(ws + OFF_ACT);
  for (int it = 0;; it++) {
    int mtile, nti; bool valid;
    if (!next_tile(it, 128, 44, 16, 4, mtile, nti, valid)) break;
    if (!valid) continue;
    const int m0 = mtile * 128;
    const int rbase = m0 + wave * 32 + quad * 4;
    f32x4 acc[2][8];
    zero_acc(acc);
    gemm_acc(acc, h2 + (size_t)m0 * 1024, 1024, wgu + (size_t)(nti * 128) * 1024, 1024, 1024, sA, sB);
#pragma unroll
    for (int mt = 0; mt < 2; mt++)
#pragma unroll
      for (int nt = 0; nt < 4; nt++)
#pragma unroll
        for (int i = 0; i < 4; i++)
          act[(size_t)(rbase + mt * 16 + i) * 2816 + nti * 64 + nt * 16 + r16] = f2bf(siluf_(acc[mt][nt][i]) * acc[mt][nt + 4][i]);
  }
}

__device__ __forceinline__ void phase10(const Params& p) {
  char* ws = p.ws;
  const int lane = otid() & 63, wave = otid() >> 6;
  const int gw = obid() * 4 + wave, nw = gridDim.x * 4;
  const float* f = (const float*)(ws + OFF_F);
  const float* ssq = (const float*)(ws + OFF_SSQ2);
  for (int row0 = gw * 4; row0 < S_; row0 += nw * 4) {
    f32x4 xv[4][4], fv[4][4], g[4];
    float rs[4];
#pragma unroll
    for (int r = 0; r < 4; r++)
#pragma unroll
      for (int i = 0; i < 4; i++) {
        xv[r][i] = ((const f32x4*)(p.out + (size_t)(row0 + r) * 1024))[lane + 64 * i];
        fv[r][i] = ((const f32x4*)(f + (size_t)(row0 + r) * 1024))[lane + 64 * i];
      }
#pragma unroll
    for (int i = 0; i < 4; i++) g[i] = ((const f32x4*)p.g_post_ffn)[lane + 64 * i];
#pragma unroll
    for (int r = 0; r < 4; r++) {
      float ss = 0.f;
#pragma unroll
      for (int i = 0; i < 8; i++) ss += ssq[(size_t)(row0 + r) * 8 + i];
      rs[r] = rsqrtf(ss * (1.f / 1024.f) + 1e-6f);
    }
#pragma unroll
    for (int r = 0; r < 4; r++)
#pragma unroll
      for (int i = 0; i < 4; i++) ((f32x4*)(p.out + (size_t)(row0 + r) * 1024))[lane + 64 * i] = xv[r][i] + fv[r][i] * g[i] * rs[r];
  }
}

__device__ __forceinline__ void run_phase(const Params& p, int ph, char* smem) {
  switch (ph) {
    case 0: phase0(p, smem); break;
    case 1: phase1(p, smem); break;
    case 2: phase2(p, smem); phase2_ut(p, smem); for (int t = obid(); t < 1024; t += gridDim.x) gr_tile(p, t, smem); break;
    case 3: phase3(p, smem); break;
    case 4: phase4(p, smem); break;
    case 5: phase5(p, smem); break;
    case 6: phase_proj(p, smem, (const u16*)(p.ws + OFF_MERGED), 1024, (const u16*)(p.ws + OFF_WOUT), (float*)(p.ws + OFF_MIX), (float*)(p.ws + OFF_SSQ1)); break;
    case 7: phase7(p); break;
    case 8: phase8(p, smem); break;
    case 9: phase_proj(p, smem, (const u16*)(p.ws + OFF_ACT), 2816, (const u16*)(p.ws + OFF_WD), (float*)(p.ws + OFF_F), (float*)(p.ws + OFF_SSQ2)); break;
    case 10: phase10(p); break;
  }
}

#define NPHASE 11

#if ONE_LAUNCH
#define XB_XCNT(j) (64 * (j))
#define XB_XSUB(j) (1024 + 64 * (j))
#define XB_XGEN(j) (2048 + 64 * (j))
#define XB_TOP 3072
#define XB_TOPGEN 3136
#define XB_WORDS 3200
__device__ __forceinline__ unsigned bar_ld(unsigned* p) { return __hip_atomic_load(p, __ATOMIC_RELAXED, __HIP_MEMORY_SCOPE_AGENT); }
__device__ __forceinline__ unsigned bar_add(unsigned* p) { return __hip_atomic_fetch_add(p, 1u, __ATOMIC_RELAXED, __HIP_MEMORY_SCOPE_AGENT); }
#define BAR_SPIN(cond) do { unsigned sp_ = 0; while (cond) { __builtin_amdgcn_s_sleep(1); if (++sp_ > (1u << 22)) break; } } while (0)
__device__ __forceinline__ unsigned xcc_id() { return (unsigned)__builtin_amdgcn_s_getreg((3 << 11) | 20) & 0xFu; }
__device__ __forceinline__ void fast_grid_barrier(unsigned* bar, unsigned x, volatile unsigned* st) {
  asm volatile("s_waitcnt vmcnt(0)" ::: "memory");
  __syncthreads();
  if (threadIdx.x == 0) {
    __builtin_amdgcn_s_waitcnt(0);
    unsigned nloc = st[0], nx = st[1];
    if (nloc == 0u) {
      const unsigned G = gridDim.x;
      unsigned sp = 0u;
      for (;;) {
        unsigned sum = 0u, cnt = 0u, mine = 0u;
#pragma unroll
        for (unsigned j = 0; j < 16; ++j) { const unsigned c = bar_ld(&bar[XB_XCNT(j)]); sum += c; cnt += (c > 0u) ? 1u : 0u; mine = (j == x) ? c : mine; }
        nloc = mine > 0u ? mine : 1u; nx = cnt > 0u ? cnt : 1u;
        if (sum == G) break;
        __builtin_amdgcn_s_sleep(1);
        if (++sp > (1u << 22)) break;
      }
      st[0] = nloc; st[1] = nx;
    }
    const unsigned old = bar_add(&bar[XB_XSUB(x)]);
    const unsigned gen = old / nloc;
    if (old + 1u == (gen + 1u) * nloc) {
      __builtin_amdgcn_fence(__ATOMIC_RELEASE, "agent");
      asm volatile("s_waitcnt vmcnt(0)" ::: "memory");
      const unsigned og = bar_add(&bar[XB_TOP]);
      const unsigned tg = og / nx;
      if (og + 1u == (tg + 1u) * nx) bar_add(&bar[XB_TOPGEN]);
      else BAR_SPIN(bar_ld(&bar[XB_TOPGEN]) == tg);
      __builtin_amdgcn_fence(__ATOMIC_ACQUIRE, "agent");
      bar_add(&bar[XB_XGEN(x)]);
      asm volatile("s_waitcnt vmcnt(0)" ::: "memory");
    } else {
      BAR_SPIN(bar_ld(&bar[XB_XGEN(x)]) == gen);
      __builtin_amdgcn_fence(__ATOMIC_ACQUIRE, "agent");
      asm volatile("s_waitcnt vmcnt(0)" ::: "memory");
    }
  }
  __syncthreads();
}

__global__ void __launch_bounds__(256, 2) mega_kernel(Params p) {
  extern __shared__ __attribute__((aligned(16))) char smem[];
  cg::grid_group grid = cg::this_grid();
#ifndef REPMASK
#define REPMASK 0
#endif
  if (threadIdx.x == 0) {
    volatile unsigned* bst = (volatile unsigned*)(smem + 73728);
    bst[0] = 0u; bst[1] = 0u;
    bar_add((unsigned*)(p.ws + OFF_BAR) + XB_XCNT(xcc_id()));
  }
  __syncthreads();
  for (int ph = 0; ph < NPHASE; ph++) {
    run_phase(p, ph, smem);
    if ((REPMASK >> ph) & 1) { grid.sync(); run_phase(p, ph, smem); }
    if (ph + 1 < NPHASE) fast_grid_barrier((unsigned*)(p.ws + OFF_BAR), xcc_id(), (volatile unsigned*)(smem + 73728));
    if (p.ws == nullptr) grid.sync();
  }
}

#else
template <int PH>
__global__ void __launch_bounds__(256, 2) phase_kernel(Params p) {
  extern __shared__ __attribute__((aligned(16))) char smem[];
  run_phase(p, PH, smem);
}

#endif

extern "C" void kernel_launch(void* const* d_in, const int* in_sizes, int n_in, void* d_out, int out_size, void* d_ws, size_t ws_size,
                              hipStream_t stream) {
  Params p{};
  p.x = (const float*)d_in[0]; p.g_pre_mix = (const float*)d_in[1]; p.w_in = (const float*)d_in[2];
  p.cpk = (const float*)d_in[3]; p.cw1k = (const float*)d_in[4]; p.cw2k = (const float*)d_in[5];
  p.cpv = (const float*)d_in[6]; p.cw1v = (const float*)d_in[7]; p.cw2v = (const float*)d_in[8];
  p.wba = (const float*)d_in[9]; p.wbb = (const float*)d_in[10]; p.wout = (const float*)d_in[11];
  p.g_post_mix = (const float*)d_in[12]; p.g_pre_ffn = (const float*)d_in[13];
  p.wg = (const float*)d_in[14]; p.wu = (const float*)d_in[15]; p.wd = (const float*)d_in[16]; p.g_post_ffn = (const float*)d_in[17];
  p.out = (float*)d_out; p.ws = (char*)d_ws;
#if ONE_LAUNCH
  static int grid_blocks = 0;
  if (!grid_blocks) {
    int dev = 0, cus = 0, per_cu = 0;
    hipGetDevice(&dev);
    hipDeviceGetAttribute(&cus, hipDeviceAttributeMultiprocessorCount, dev);
    hipFuncSetAttribute((const void*)mega_kernel, hipFuncAttributeMaxDynamicSharedMemorySize, SMEM_BYTES);
    hipOccupancyMaxActiveBlocksPerMultiprocessor(&per_cu, mega_kernel, 256, SMEM_BYTES);
    if (per_cu > 2) per_cu = 2;
    if (per_cu < 1) per_cu = 1;
    grid_blocks = cus * per_cu;
  }
  hipMemsetAsync((char*)d_ws + OFF_CTR, 0, 4096 + 4 * XB_WORDS, stream);
  void* args[] = {&p};
  hipError_t e = hipLaunchCooperativeKernel((void*)mega_kernel, dim3(grid_blocks), dim3(256), args, SMEM_BYTES, stream);
  if (e != hipSuccess) fprintf(stderr, "cooperative launch failed: %s (grid %d)\n", hipGetErrorString(e), grid_blocks);
#else
  hipLaunchKernelGGL(phase_kernel<0>, dim3(512), dim3(256), SMEM_BYTES, stream, p);
  hipLaunchKernelGGL(phase_kernel<1>, dim3(512), dim3(256), SMEM_BYTES, stream, p);
  hipLaunchKernelGGL(phase_kernel<2>, dim3(512), dim3(256), SMEM_BYTES, stream, p);
  hipLaunchKernelGGL(phase_kernel<3>, dim3(512), dim3(256), SMEM_BYTES, stream, p);
  hipLaunchKernelGGL(phase_kernel<4>, dim3(512), dim3(256), SMEM_BYTES, stream, p);
  hipLaunchKernelGGL(phase_kernel<5>, dim3(512), dim3(256), SMEM_BYTES, stream, p);
  hipLaunchKernelGGL(phase_kernel<6>, dim3(512), dim3(256), SMEM_BYTES, stream, p);
  hipLaunchKernelGGL(phase_kernel<7>, dim3(512), dim3(256), SMEM_BYTES, stream, p);
  hipLaunchKernelGGL(phase_kernel<8>, dim3(512), dim3(256), SMEM_BYTES, stream, p);
  hipLaunchKernelGGL(phase_kernel<9>, dim3(512), dim3(256), SMEM_BYTES, stream, p);
  hipLaunchKernelGGL(phase_kernel<10>, dim3(512), dim3(256), SMEM_BYTES, stream, p);
#endif
}
```

```cpp
#include <hip/hip_runtime.h>
#include <hip/hip_bf16.h>
#include <hip/hip_cooperative_groups.h>
#include <cstdio>
namespace cg = cooperative_groups;

#ifndef ONE_LAUNCH
#define ONE_LAUNCH 1
#endif

typedef unsigned short u16;
using bf16x8 = __attribute__((ext_vector_type(8))) short;
using f32x4 = __attribute__((ext_vector_type(4))) float;
using u32x4 = __attribute__((ext_vector_type(4))) unsigned;
using u32x2 = __attribute__((ext_vector_type(2))) unsigned;
using f16x8 = __attribute__((ext_vector_type(8))) _Float16;

#define S_ 16384
#define NEGF (-1e30f)
#define BIGF (1e9f)

struct Params {
  const float *x, *g_pre_mix, *w_in, *cpk, *cw1k, *cw2k, *cpv, *cw1v, *cw2v, *wba, *wbb, *wout, *g_post_mix, *g_pre_ffn, *wg, *wu, *wd, *g_post_ffn;
  float* out;
  char* ws;
};

constexpr size_t MB = (size_t)1 << 20;
constexpr size_t OFF_HH = 0, OFF_HL = 32 * MB, OFF_RTB = 32 * MB, OFF_QHI = 64 * MB, OFF_QLO = 96 * MB, OFF_YR = 96 * MB,
                 OFF_QR = 128 * MB, OFF_KR = 144 * MB, OFF_KRTD = 160 * MB, OFF_VRT = 176 * MB, OFF_KS = 208 * MB, OFF_KW = 212 * MB,
                 OFF_VST = 216 * MB, OFF_VWT = 220 * MB, OFF_PBUF = 208 * MB, OFF_GATES = 224 * MB, OFF_KCH = 227 * MB,
                 OFF_KCL = 227 * MB + 256 * 1024, OFF_VCT = 227 * MB + 512 * 1024, OFF_WBA = 228 * MB, OFF_WBB = 230 * MB,
                 OFF_WOUT = 232 * MB, OFF_WGU = 234 * MB, OFF_WD = 245 * MB, OFF_W1LO = 250 * MB + 512 * 1024,
                 OFF_SSQ1 = 253 * MB, OFF_SSQ2 = 253 * MB + 512 * 1024, OFF_CTR = 254 * MB, OFF_BAR = 254 * MB + 4096,
                 OFF_MERGEDF = 128 * MB, OFF_MERGED = 32 * MB, OFF_MIX = 128 * MB, OFF_H2 = 0, OFF_ACT = 32 * MB, OFF_F = 128 * MB;
constexpr size_t OO_W1T = 0, OO_CS64 = 14 * MB, OO_CS128 = 18 * MB, OO_UT = 14 * MB, OO_KC = 46 * MB, OO_VC = 54 * MB, OO_GB = 46 * MB;
constexpr size_t OFF_G = 32 * MB;
constexpr size_t OFF_GA = 160 * MB;

__device__ __forceinline__ int otid() { int t = threadIdx.x; asm volatile("" : "+v"(t)); return t; }
__device__ __forceinline__ int obid() { int b = blockIdx.x; asm volatile("" : "+s"(b)); return b; }
__device__ __forceinline__ u16 f2bf(float f) {
  unsigned u = __float_as_uint(f);
  u += 0x7fffu + ((u >> 16) & 1u);
  return (u16)(u >> 16);
}
__device__ __forceinline__ u16 f2h(float f) { union { _Float16 h; u16 u; } t; t.h = (_Float16)f; return t.u; }
__device__ __forceinline__ unsigned packh2(float a, float b) { return (unsigned)f2h(a) | ((unsigned)f2h(b) << 16); }
__device__ __forceinline__ f32x4 mfma16(bf16x8 a, bf16x8 b, f32x4 c) {
  union { bf16x8 s; f16x8 h; } ta, tb; ta.s = a; tb.s = b;
  return __builtin_amdgcn_mfma_f32_16x16x32_f16(ta.h, tb.h, c, 0, 0, 0);
}
__device__ __forceinline__ float bf2f(u16 h) { return __uint_as_float(((unsigned)h) << 16); }
__device__ __forceinline__ unsigned pack2(float a, float b) { return (unsigned)f2bf(a) | ((unsigned)f2bf(b) << 16); }
__device__ __forceinline__ float sigmoidf_(float x) { return 1.f / (1.f + __expf(-x)); }
__device__ __forceinline__ float siluf_(float x) { return x / (1.f + __expf(-x)); }

__device__ __forceinline__ float logg_of(int hd) {
  return hd == 0 ? -0.0317486972f : (hd == 1 ? -0.0157483574f : (hd == 2 ? -0.00784317777f : -0.00391389942f));
}

#define BK 64
#define LDT 72
#define SMEM_BYTES 73744

__device__ __forceinline__ void zero_acc(f32x4 (&acc)[2][8]) {
#pragma unroll
  for (int a = 0; a < 2; a++)
#pragma unroll
    for (int b = 0; b < 8; b++) acc[a][b] = f32x4{0.f, 0.f, 0.f, 0.f};
}

#define GBUF (2 * 128 * LDT)
__device__ __forceinline__ void gemm_store(const u32x4 (&ra)[4], const u32x4 (&rb)[4], u16* sA, int lrow, int lc) {
#pragma unroll
  for (int i = 0; i < 4; i++) {
    *(u32x4*)(sA + (lrow + i * 32) * LDT + lc) = ra[i];
    *(u32x4*)(sA + 128 * LDT + (lrow + i * 32) * LDT + lc) = rb[i];
  }
}
__device__ __forceinline__ void gemm_load(u32x4 (&ra)[4], u32x4 (&rb)[4], const u16* pa, const u16* pb, int lda, int ldb) {
#pragma unroll
  for (int i = 0; i < 4; i++) {
    ra[i] = *(const u32x4*)(pa + (size_t)(i * 32) * lda);
    rb[i] = *(const u32x4*)(pb + (size_t)(i * 32) * ldb);
  }
}
template <bool F16>
__device__ __forceinline__ void gemm_compute(f32x4 (&acc)[2][8], const u16* sA, int wave, int quad, int r16) {
  const u16* sB = sA + 128 * LDT;
  __builtin_amdgcn_s_setprio(2);
#pragma unroll
  for (int ks = 0; ks < 2; ks++) {
    bf16x8 af[2];
#pragma unroll
    for (int mt = 0; mt < 2; mt++) af[mt] = *(const bf16x8*)(sA + (wave * 32 + mt * 16 + r16) * LDT + ks * 32 + quad * 8);
#pragma unroll
    for (int nh = 0; nh < 2; nh++) {
      bf16x8 bfr[4];
#pragma unroll
      for (int nt = 0; nt < 4; nt++) bfr[nt] = *(const bf16x8*)(sB + ((nh * 4 + nt) * 16 + r16) * LDT + ks * 32 + quad * 8);
#pragma unroll
      for (int mt = 0; mt < 2; mt++)
#pragma unroll
        for (int nt = 0; nt < 4; nt++)
          acc[mt][nh * 4 + nt] = F16 ? mfma16(af[mt], bfr[nt], acc[mt][nh * 4 + nt])
                                     : __builtin_amdgcn_mfma_f32_16x16x32_bf16(af[mt], bfr[nt], acc[mt][nh * 4 + nt], 0, 0, 0);
    }
  }
  __builtin_amdgcn_s_setprio(0);
}

template <bool F16 = false>
__device__ __forceinline__ void gemm_acc(f32x4 (&acc)[2][8], const u16* A, int lda, const u16* B, int ldb, int K, u16* sA, u16*  ) {
  const int tid = otid(), lane = tid & 63, wave = tid >> 6, quad = lane >> 4, r16 = lane & 15;
  const int lrow = tid >> 3, lc = (tid & 7) * 8;
  const u16* pa = A + (size_t)lrow * lda + lc;
  const u16* pb = B + (size_t)lrow * ldb + lc;
  u16* s0 = sA;
  u16* s1 = sA + GBUF;
  u32x4 ra0[4], rb0[4], ra1[4], rb1[4];
  const int nk = K / BK;
  gemm_load(ra0, rb0, pa, pb, lda, ldb);
  gemm_load(ra1, rb1, pa + BK, pb + BK, lda, ldb);
  __syncthreads();
  gemm_store(ra0, rb0, s0, lrow, lc);
  if (nk > 2) gemm_load(ra0, rb0, pa + 2 * BK, pb + 2 * BK, lda, ldb);
  __syncthreads();
  for (int kt = 0; kt < nk; kt += 2) {
    gemm_compute<F16>(acc, s0, wave, quad, r16);
    __builtin_amdgcn_sched_barrier(0);
    gemm_store(ra1, rb1, s1, lrow, lc);
    if (kt + 3 < nk) gemm_load(ra1, rb1, pa + (kt + 3) * BK, pb + (kt + 3) * BK, lda, ldb);
    __syncthreads();
    gemm_compute<F16>(acc, s1, wave, quad, r16);
    __builtin_amdgcn_sched_barrier(0);
    if (kt + 2 < nk) {
      gemm_store(ra0, rb0, s0, lrow, lc);
      if (kt + 4 < nk) gemm_load(ra0, rb0, pa + (kt + 4) * BK, pb + (kt + 4) * BK, lda, ldb);
    }
    __syncthreads();
  }
}

__device__ __forceinline__ void gemm_acc_wide(f32x4 (&acc)[2][16], const u16* A, int lda, const u16* B, int ldb, int K, u16* sA) {
  const int tid = otid(), lane = tid & 63, wave = tid >> 6, quad = lane >> 4, r16 = lane & 15;
  const int lrow = tid >> 3, lc = (tid & 7) * 8;
  const u16* pa = A + (size_t)lrow * lda + lc;
  const u16* pb = B + (size_t)lrow * ldb + lc;
  u16* sB = sA + 128 * LDT;
  u32x4 ra[4], rb[8];
#pragma unroll
  for (int i = 0; i < 4; i++) ra[i] = *(const u32x4*)(pa + (size_t)(i * 32) * lda);
#pragma unroll
  for (int i = 0; i < 8; i++) rb[i] = *(const u32x4*)(pb + (size_t)(i * 32) * ldb);
  const int nk = K / BK;
  for (int kt = 0; kt < nk; kt++) {
    __syncthreads();
#pragma unroll
    for (int i = 0; i < 4; i++) *(u32x4*)(sA + (lrow + i * 32) * LDT + lc) = ra[i];
#pragma unroll
    for (int i = 0; i < 8; i++) *(u32x4*)(sB + (lrow + i * 32) * LDT + lc) = rb[i];
    __syncthreads();
    if (kt + 1 < nk) {
      pa += BK; pb += BK;
#pragma unroll
      for (int i = 0; i < 4; i++) ra[i] = *(const u32x4*)(pa + (size_t)(i * 32) * lda);
#pragma unroll
      for (int i = 0; i < 8; i++) rb[i] = *(const u32x4*)(pb + (size_t)(i * 32) * ldb);
    }
    __builtin_amdgcn_s_setprio(2);
#pragma unroll
    for (int ks = 0; ks < 2; ks++) {
      bf16x8 af[2];
#pragma unroll
      for (int mt = 0; mt < 2; mt++) af[mt] = *(const bf16x8*)(sA + (wave * 32 + mt * 16 + r16) * LDT + ks * 32 + quad * 8);
#pragma unroll
      for (int nq = 0; nq < 4; nq++) {
        bf16x8 bfr[4];
#pragma unroll
        for (int nt = 0; nt < 4; nt++) bfr[nt] = *(const bf16x8*)(sB + ((nq * 4 + nt) * 16 + r16) * LDT + ks * 32 + quad * 8);
#pragma unroll
        for (int mt = 0; mt < 2; mt++)
#pragma unroll
          for (int nt = 0; nt < 4; nt++)
            acc[mt][nq * 4 + nt] = __builtin_amdgcn_mfma_f32_16x16x32_bf16(af[mt], bfr[nt], acc[mt][nq * 4 + nt], 0, 0, 0);
      }
    }
    __builtin_amdgcn_s_setprio(0);
  }
  __syncthreads();
}

__device__ const float ROPE_INV[96] = {1.0f, 0.749894202f, 0.562341332f, 0.421696514f, 0.316227764f, 0.237137377f, 0.177827939f, 0.133352146f, 0.100000001f, 0.0749894232f, 0.0562341325f, 0.0421696492f, 0.0316227749f, 0.0237137377f, 0.0177827943f, 0.013335214f, 0.00999999978f, 0.00749894232f, 0.00562341325f, 0.00421696482f, 0.00316227763f, 0.00237137382f, 0.00177827943f, 0.00133352145f, 0.00100000005f, 0.000749894185f, 0.000562341302f, 0.000421696517f, 0.000316227757f, 0.00023713737f, 0.00017782794f, 0.00013335215f, 1.0f, 0.865964353f, 0.749894202f, 0.649381638f, 0.562341332f, 0.486967534f, 0.421696514f, 0.365174115f, 0.316227764f, 0.273841977f, 0.237137377f, 0.2053525f, 0.177827939f, 0.153992653f, 0.133352146f, 0.115478195f, 0.100000001f, 0.0865964293f, 0.0749894232f, 0.0649381652f, 0.0562341325f, 0.0486967526f, 0.0421696492f, 0.0365174115f, 0.0316227749f, 0.0273841955f, 0.0237137377f, 0.0205352511f, 0.0177827943f, 0.0153992651f, 0.013335214f, 0.0115478197f, 0.00999999978f, 0.00865964312f, 0.00749894232f, 0.00649381615f, 0.00562341325f, 0.00486967526f, 0.00421696482f, 0.00365174119f, 0.00316227763f, 0.00273841969f, 0.00237137382f, 0.00205352507f, 0.00177827943f, 0.00153992651f, 0.00133352145f, 0.00115478202f, 0.00100000005f, 0.000865964335f, 0.000749894185f, 0.000649381604f, 0.000562341302f, 0.000486967532f, 0.000421696517f, 0.000365174114f, 0.000316227757f, 0.000273841957f, 0.00023713737f, 0.00020535251f, 0.00017782794f, 0.00015399266f, 0.00013335215f, 0.0001154782f};

__device__ __forceinline__ bool next_tile(int it, int Mt, int Nt, int SM, int SN, int& mt, int& nt, bool& valid) {
  const int G = gridDim.x, bid = obid();
  if (G == 512) {
    const int xcd = bid & 7, l = bid >> 3;
    const int nsm = (Mt + SM - 1) / SM, nsn = (Nt + SN - 1) / SN;
    const int sb = it * 8 + xcd;
    if (sb >= nsm * nsn) return false;
    const int sm = sb % nsm, sn = sb / nsm;
    mt = sm * SM + l / SN; nt = sn * SN + l % SN;
    valid = (mt < Mt) && (nt < Nt);
    return true;
  } else {
    const int task = bid + it * G;
    if (task >= Mt * Nt) return false;
    mt = task / Nt; nt = task % Nt; valid = true;
    return true;
  }
}

__device__ __forceinline__ void tconv_tile(const float* src, int ld_src, int k0, int n_src0, int nvalid, u16* dst_hi, u16* dst_lo, int ld_dst,
                                           int n_dst0, float* tile) {
  const int tid = otid();
  __syncthreads();
#pragma unroll
  for (int i = 0; i < 4; i++) {
    const int r = i * 16 + (tid >> 4), c = (tid & 15) * 4;
    float4 v = float4{0.f, 0.f, 0.f, 0.f};
    if (c < nvalid) v = *(const float4*)(src + (size_t)(k0 + r) * ld_src + n_src0 + c);
    tile[r * 65 + c] = v.x; tile[r * 65 + c + 1] = v.y; tile[r * 65 + c + 2] = v.z; tile[r * 65 + c + 3] = v.w;
  }
  __syncthreads();
  const int n = tid >> 2, kc = (tid & 3) * 16;
  unsigned hi[8], lo[8];
#pragma unroll
  for (int e = 0; e < 8; e++) {
    float a = tile[(kc + 2 * e) * 65 + n], b = tile[(kc + 2 * e + 1) * 65 + n];
    u16 ah = f2bf(a), bh = f2bf(b);
    hi[e] = (unsigned)ah | ((unsigned)bh << 16);
    lo[e] = packh2(a, b);
  }
  u16* d = dst_hi + (size_t)(n_dst0 + n) * ld_dst + k0 + kc;
  *(uint4*)d = uint4{hi[0], hi[1], hi[2], hi[3]};
  *(uint4*)(d + 8) = uint4{hi[4], hi[5], hi[6], hi[7]};
  if (dst_lo) {
    u16* dl = dst_lo + (size_t)(n_dst0 + n) * ld_dst + k0 + kc;
    *(uint4*)dl = uint4{lo[0], lo[1], lo[2], lo[3]};
    *(uint4*)(dl + 8) = uint4{lo[4], lo[5], lo[6], lo[7]};
  }
}

__device__ __forceinline__ void wdecode(const Params& p, int task, const float*& src, int& ld_src, int& k0, int& ns, int& nv, u16*& dhi, u16*& dlo,
                                        int& ld_dst, int& nd) {
  char* ws = p.ws;
  char* oo = (char*)p.out;
  nv = 64; dlo = nullptr;
  if (task < 1760) {
    const int a = task >> 4, kt = task & 15;
    nd = a * 64;
    if (nd < 1792) ns = nd;
    else if (nd == 1792) { ns = 1792; nv = 48; }
    else if (nd == 1856) { ns = 0; nv = 0; }
    else ns = nd - 80;
    src = p.w_in; ld_src = 6960; k0 = kt * 64; dhi = (u16*)(oo + OO_W1T); dlo = (nd < 1152) ? (u16*)(ws + OFF_W1LO) : nullptr; ld_dst = 1024;
  } else if (task < 2528) {
    const int t = task - 1760, wsel = t >> 8, r = t & 255, a = r >> 4, kt = r & 15;
    src = wsel == 0 ? p.wba : (wsel == 1 ? p.wbb : p.wout);
    dhi = (u16*)(ws + (wsel == 0 ? OFF_WBA : (wsel == 1 ? OFF_WBB : OFF_WOUT)));
    ld_src = 1024; k0 = kt * 64; ns = a * 64; ld_dst = 1024; nd = a * 64;
  } else if (task < 3936) {
    const int t = task - 2528, a = t >> 4, kt = t & 15;
    src = (a & 1) ? p.wu : p.wg;
    ld_src = 2816; k0 = kt * 64; ns = (a >> 1) * 64; dhi = (u16*)(ws + OFF_WGU); ld_dst = 1024; nd = a * 64;
  } else {
    const int t = task - 3936, a = t / 44, kt = t % 44;
    src = p.wd; ld_src = 1024; k0 = kt * 64; ns = a * 64; dhi = (u16*)(ws + OFF_WD); ld_dst = 2816; nd = a * 64;
  }
}
__device__ __forceinline__ void tconv_load(f32x4 (&v)[4], const float* src, int ld_src, int k0, int ns, int nv, int tid) {
#pragma unroll
  for (int i = 0; i < 4; i++) {
    const int r = i * 16 + (tid >> 4), c = (tid & 15) * 4;
    v[i] = f32x4{0.f, 0.f, 0.f, 0.f};
    if (c < nv) v[i] = *(const f32x4*)(src + (size_t)(k0 + r) * ld_src + ns + c);
  }
}
__device__ __forceinline__ void tconv_finish(const f32x4 (&v)[4], int k0, u16* dst_hi, u16* dst_lo, int ld_dst, int n_dst0, float* tile, int tid) {
  __syncthreads();
#pragma unroll
  for (int i = 0; i < 4; i++) {
    const int r = i * 16 + (tid >> 4), c = (tid & 15) * 4;
    tile[r * 65 + c] = v[i][0]; tile[r * 65 + c + 1] = v[i][1]; tile[r * 65 + c + 2] = v[i][2]; tile[r * 65 + c + 3] = v[i][3];
  }
  __syncthreads();
  const int n = tid >> 2, kc = (tid & 3) * 16;
  unsigned hi[8], lo[8];
#pragma unroll
  for (int e = 0; e < 8; e++) {
    float a = tile[(kc + 2 * e) * 65 + n], b = tile[(kc + 2 * e + 1) * 65 + n];
    u16 ah = f2bf(a), bh = f2bf(b);
    hi[e] = (unsigned)ah | ((unsigned)bh << 16);
    lo[e] = packh2(a, b);
  }
  u16* d = dst_hi + (size_t)(n_dst0 + n) * ld_dst + k0 + kc;
  *(u32x4*)d = u32x4{hi[0], hi[1], hi[2], hi[3]};
  *(u32x4*)(d + 8) = u32x4{hi[4], hi[5], hi[6], hi[7]};
  if (dst_lo) {
    u16* dl = dst_lo + (size_t)(n_dst0 + n) * ld_dst + k0 + kc;
    *(u32x4*)dl = u32x4{lo[0], lo[1], lo[2], lo[3]};
    *(u32x4*)(dl + 8) = u32x4{lo[4], lo[5], lo[6], lo[7]};
  }
}

__device__ __forceinline__ void phase0(const Params& p, char* smem) {
  char* ws = p.ws;
  char* oo = (char*)p.out;
  float* tile = (float*)smem;
  const int tid = otid(), lane = tid & 63, wave = tid >> 6;
  if (obid() == 0 && tid < 4) ((unsigned*)(ws + OFF_CTR))[tid] = 0u;
  {
    const int G = gridDim.x;
    int task = obid();
    const float* srcA; int ldsA, k0A, nsA, nvA, lddA, ndA; u16 *dhiA, *dloA;
    f32x4 vA[4], vB[4];
    if (task < 4640) { wdecode(p, task, srcA, ldsA, k0A, nsA, nvA, dhiA, dloA, lddA, ndA); tconv_load(vA, srcA, ldsA, k0A, nsA, nvA, tid); }
    while (task < 4640) {
      const int nt = task + G;
      const float* srcB = srcA; int ldsB = ldsA, k0B = k0A, nsB = nsA, nvB = nvA, lddB = lddA, ndB = ndA; u16 *dhiB = dhiA, *dloB = dloA;
      if (nt < 4640) { wdecode(p, nt, srcB, ldsB, k0B, nsB, nvB, dhiB, dloB, lddB, ndB); tconv_load(vB, srcB, ldsB, k0B, nsB, nvB, tid); }
      tconv_finish(vA, k0A, dhiA, dloA, lddA, ndA, tile, tid);
#pragma unroll
      for (int i = 0; i < 4; i++) vA[i] = vB[i];
      srcA = srcB; ldsA = ldsB; k0A = k0B; nsA = nsB; nvA = nvB; lddA = lddB; ndA = ndB; dhiA = dhiB; dloA = dloB;
      task = nt;
    }
  }
  const int gw = obid() * 4 + wave, nw = gridDim.x * 4;
  u16* hh = (u16*)(ws + OFF_HH);
  u16* hl = (u16*)(ws + OFF_HL);
  for (int row0 = gw * 4; row0 < S_; row0 += nw * 4) {
    f32x4 v[4][4], g[4];
    float ss[4];
#pragma unroll
    for (int r = 0; r < 4; r++)
#pragma unroll
      for (int i = 0; i < 4; i++) v[r][i] = ((const f32x4*)(p.x + (size_t)(row0 + r) * 1024))[lane + 64 * i];
#pragma unroll
    for (int i = 0; i < 4; i++) g[i] = ((const f32x4*)p.g_pre_mix)[lane + 64 * i];
#pragma unroll
    for (int r = 0; r < 4; r++) {
      ss[r] = 0.f;
#pragma unroll
      for (int i = 0; i < 4; i++) ss[r] += v[r][i][0] * v[r][i][0] + v[r][i][1] * v[r][i][1] + v[r][i][2] * v[r][i][2] + v[r][i][3] * v[r][i][3];
    }
#pragma unroll
    for (int o = 32; o >= 1; o >>= 1)
#pragma unroll
      for (int r = 0; r < 4; r++) ss[r] += __shfl_xor(ss[r], o);
#pragma unroll
    for (int r = 0; r < 4; r++) {
      const float rs = rsqrtf(ss[r] * (1.f / 1024.f) + 1e-6f);
#pragma unroll
      for (int i = 0; i < 4; i++) {
        const f32x4 y = v[r][i] * rs * g[i];
        u32x2 H, L;
        H.x = pack2(y[0], y[1]); H.y = pack2(y[2], y[3]);
        L.x = packh2(y[0], y[1]); L.y = packh2(y[2], y[3]);
        *(u32x2*)(hh + (size_t)(row0 + r) * 1024 + (lane + 64 * i) * 4) = H;
        *(u32x2*)(hl + (size_t)(row0 + r) * 1024 + (lane + 64 * i) * 4) = L;
      }
    }
  }
  float2* cs64 = (float2*)(oo + OO_CS64);
  float2* cs128 = (float2*)(oo + OO_CS128);
  const int gt = obid() * 256 + tid, nt = gridDim.x * 256;
  for (int e = gt; e < S_ * 96; e += nt) {
    int t = e / 96, i = e % 96;
    float ang = (float)t * ROPE_INV[i];
    float sn, cn;
    sincosf(ang, &sn, &cn);
    if (i < 32) cs64[t * 32 + i] = float2{cn, sn};
    else cs128[t * 64 + (i - 32)] = float2{cn, sn};
  }
}

__device__ __forceinline__ void p1_epilogue(const Params& p, int nti, int m0, f32x4 (&acc)[2][8]) {
  char* ws = p.ws;
  char* oo = (char*)p.out;
  const int tid = otid(), lane = tid & 63, wave = tid >> 6, quad = lane >> 4, r16 = lane & 15;
  const int rbase = m0 + wave * 32 + quad * 4;
  const bool rope64 = (nti <= 8) || nti == 10 || nti == 12;
  const bool rope128 = (nti >= 15 && nti <= 22);
  if (rope64) {
    const float2* cs64 = (const float2*)(oo + OO_CS64);
#pragma unroll
    for (int mt = 0; mt < 2; mt++)
#pragma unroll
      for (int i = 0; i < 4; i++) {
        int tok = rbase + mt * 16 + i;
#pragma unroll
        for (int j = 0; j < 2; j++) {
          float2 cs = cs64[tok * 32 + j * 16 + r16];
#pragma unroll
          for (int hh = 0; hh < 2; hh++) {
            float x1 = acc[mt][hh * 4 + j][i], x2 = acc[mt][hh * 4 + j + 2][i];
            acc[mt][hh * 4 + j][i] = x1 * cs.x - x2 * cs.y;
            acc[mt][hh * 4 + j + 2][i] = x2 * cs.x + x1 * cs.y;
          }
        }
      }
  } else if (rope128) {
    const float2* cs128 = (const float2*)(oo + OO_CS128);
    const float sc = (nti <= 18) ? 0.08838834764831845f : 1.f;
#pragma unroll
    for (int mt = 0; mt < 2; mt++)
#pragma unroll
      for (int i = 0; i < 4; i++) {
        int tok = rbase + mt * 16 + i;
#pragma unroll
        for (int j = 0; j < 4; j++) {
          float2 cs = cs128[tok * 64 + j * 16 + r16];
          float x1 = acc[mt][j][i], x2 = acc[mt][j + 4][i];
          acc[mt][j][i] = (x1 * cs.x - x2 * cs.y) * sc;
          acc[mt][j + 4][i] = (x2 * cs.x + x1 * cs.y) * sc;
        }
      }
  }
  if (nti < 8) {
    u16* qh = (u16*)(ws + OFF_QHI);
    u16* ql = (u16*)(ws + OFF_QLO);
#pragma unroll
    for (int mt = 0; mt < 2; mt++)
#pragma unroll
      for (int nt = 0; nt < 8; nt++)
#pragma unroll
        for (int i = 0; i < 4; i++) {
          int tok = rbase + mt * 16 + i, col = nti * 128 + nt * 16 + r16;
          float v = acc[mt][nt][i];
          qh[(size_t)tok * 1024 + col] = f2bf(v);
          ql[(size_t)tok * 1024 + col] = f2h(v);
        }
  } else if (nti == 8 || nti == 9) {
    float* dst = (float*)(oo + (nti == 8 ? OO_KC : OO_VC));
#pragma unroll
    for (int mt = 0; mt < 2; mt++)
#pragma unroll
      for (int nt = 0; nt < 8; nt++)
#pragma unroll
        for (int i = 0; i < 4; i++) dst[(size_t)(rbase + mt * 16 + i) * 128 + nt * 16 + r16] = acc[mt][nt][i];
  } else if (nti == 10) {
    u16* dst = (u16*)(ws + OFF_KS);
#pragma unroll
    for (int mt = 0; mt < 2; mt++)
#pragma unroll
      for (int nt = 0; nt < 8; nt++)
#pragma unroll
        for (int i = 0; i < 4; i++) {
          const int tok = rbase + mt * 16 + i, col = nt * 16 + r16;
          const int kvh = col >> 6, d = col & 63;
          const size_t idx = (((((size_t)kvh * 256 + (tok >> 6)) * 4 + ((tok >> 4) & 3)) * 2 + (d >> 5)) * 64 + ((d >> 3) & 3) * 16 + (tok & 15)) * 8 + (d & 7);
          dst[idx] = f2bf(acc[mt][nt][i]);
        }
  } else if (nti == 12) {
    u16* dst = (u16*)(ws + OFF_KW);
#pragma unroll
    for (int mt = 0; mt < 2; mt++)
#pragma unroll
      for (int nt = 0; nt < 8; nt++)
#pragma unroll
        for (int i = 0; i < 4; i++) dst[(size_t)(rbase + mt * 16 + i) * 128 + nt * 16 + r16] = f2bf(acc[mt][nt][i]);
  } else if (nti == 11) {
    u16* dst = (u16*)(ws + OFF_VST);
#pragma unroll
    for (int mt = 0; mt < 2; mt++)
#pragma unroll
      for (int nt = 0; nt < 8; nt++) {
        const int tok = rbase + mt * 16, col = nt * 16 + r16;
        const int kvh = col >> 6, d = col & 63, kap = tok & 63;
        const int kk = kap >> 5, half = (kap >> 4) & 1, q = (kap >> 2) & 3;
        const size_t idx = (((((size_t)kvh * 256 + (tok >> 6)) * 2 + kk) * 4 + (d >> 4)) * 64 + q * 16 + (d & 15)) * 8 + 4 * half;
        uint2 v;
        v.x = pack2(acc[mt][nt][0], acc[mt][nt][1]);
        v.y = pack2(acc[mt][nt][2], acc[mt][nt][3]);
        *(uint2*)(dst + idx) = v;
      }
  } else if (nti == 13) {
    u16* dst = (u16*)(ws + OFF_VWT);
#pragma unroll
    for (int mt = 0; mt < 2; mt++)
#pragma unroll
      for (int nt = 0; nt < 8; nt++) {
        uint2 v;
        v.x = pack2(acc[mt][nt][0], acc[mt][nt][1]);
        v.y = pack2(acc[mt][nt][2], acc[mt][nt][3]);
        *(uint2*)(dst + (size_t)(nt * 16 + r16) * S_ + rbase + mt * 16) = v;
      }
  } else if (nti == 14) {
    float* dst = (float*)(ws + OFF_GATES);
#pragma unroll
    for (int mt = 0; mt < 2; mt++)
#pragma unroll
      for (int nt = 0; nt < 3; nt++)
#pragma unroll
        for (int i = 0; i < 4; i++) dst[(size_t)(rbase + mt * 16 + i) * 48 + nt * 16 + r16] = sigmoidf_(acc[mt][nt][i]);
  } else if (nti <= 18) {
    u16* dst = (u16*)(ws + OFF_QR);
    const int hd = nti - 15;
#pragma unroll
    for (int mt = 0; mt < 2; mt++)
#pragma unroll
      for (int nt = 0; nt < 8; nt++)
#pragma unroll
        for (int i = 0; i < 4; i++) dst[(size_t)(rbase + mt * 16 + i) * 512 + hd * 128 + nt * 16 + r16] = f2bf(acc[mt][nt][i]);
  } else if (nti <= 22) {
    u16* dst = (u16*)(ws + OFF_KR);
    u16* dstT = (u16*)(ws + OFF_KRTD);
    const int hd = nti - 19;
    const float logg = logg_of(hd);
#pragma unroll
    for (int mt = 0; mt < 2; mt++) {
      float dk[4];
#pragma unroll
      for (int i = 0; i < 4; i++) dk[i] = __expf(logg * (float)(127 - ((rbase + mt * 16 + i) & 127)));
#pragma unroll
      for (int nt = 0; nt < 8; nt++) {
#pragma unroll
        for (int i = 0; i < 4; i++) dst[(size_t)(rbase + mt * 16 + i) * 512 + hd * 128 + nt * 16 + r16] = f2bf(acc[mt][nt][i]);
        uint2 v;
        v.x = pack2(acc[mt][nt][0] * dk[0], acc[mt][nt][1] * dk[1]);
        v.y = pack2(acc[mt][nt][2] * dk[2], acc[mt][nt][3] * dk[3]);
        *(uint2*)(dstT + (size_t)(hd * 128 + nt * 16 + r16) * S_ + rbase + mt * 16) = v;
      }
    }
  } else {
    u16* dstT = (u16*)(ws + OFF_VRT);
    const int cb = (nti - 23) * 128;
#pragma unroll
    for (int mt = 0; mt < 2; mt++)
#pragma unroll
      for (int nt = 0; nt < 8; nt++) {
        uint2 v;
        v.x = pack2(acc[mt][nt][0], acc[mt][nt][1]);
        v.y = pack2(acc[mt][nt][2], acc[mt][nt][3]);
        *(uint2*)(dstT + (size_t)(cb + nt * 16 + r16) * S_ + rbase + mt * 16) = v;
      }
  }
}

__device__ __forceinline__ void phase1(const Params& p, char* smem) {
  u16* sA = (u16*)smem;
  u16* sB = sA + 128 * LDT;
  const u16* hh = (const u16*)(p.ws + OFF_HH);
  const u16* hl = (const u16*)(p.ws + OFF_HL);
  const u16* w1 = (const u16*)((char*)p.out + OO_W1T);
  const u16* w1lo = (const u16*)(p.ws + OFF_W1LO);
  for (int it = 0;; it++) {
    int mtile, nti; bool valid;
    if (!next_tile(it, 128, 31, 8, 8, mtile, nti, valid)) break;
    if (!valid) continue;
    const int m0 = mtile * 128, n0 = nti * 128;
    f32x4 acc[2][8];
    zero_acc(acc);
    if (nti < 9) gemm_acc<true>(acc, hl + (size_t)m0 * 1024, 1024, w1lo + (size_t)n0 * 1024, 1024, 1024, sA, sB);
    else gemm_acc(acc, hh + (size_t)m0 * 1024, 1024, w1 + (size_t)n0 * 1024, 1024, 1024, sA, sB);
    p1_epilogue(p, nti, m0, acc);
  }
}

__device__ __forceinline__ void phase2(const Params& p, char* smem) {
  float* tile = (float*)smem;
  float* posl = tile + 144 * 64;
  float* red = tile;
  float* hid = posl + 32 * 64;
  const int tid = otid();
  char* oo = (char*)p.out;
  for (int task = obid(); task < 512; task += gridDim.x) {
    const int which = task >> 8, head = (task >> 7) & 1, g = task & 127;
    const float* src = (const float*)(oo + (which ? OO_VC : OO_KC));
    const float* pos = which ? p.cpv : p.cpk;
    const float* w1 = which ? p.cw1v : p.cw1k;
    const float* w2 = which ? p.cw2v : p.cw2k;
    __syncthreads();
#pragma unroll
    for (int i = 0; i < 9; i++) {
      int id = tid + 256 * i, tk = id >> 4, c4 = id & 15, tok = 128 * g + tk;
      float4 v = float4{0.f, 0.f, 0.f, 0.f};
      if (tok < S_) v = *(const float4*)(src + (size_t)tok * 128 + head * 64 + c4 * 4);
      ((float4*)tile)[tk * 16 + c4] = v;
    }
#pragma unroll
    for (int i = 0; i < 2; i++) ((float4*)posl)[tid + 256 * i] = ((const float4*)pos)[tid + 256 * i];
    __syncthreads();
    const int j4 = tid & 31, kp = tid >> 5;
    float acc[9][4];
#pragma unroll
    for (int r = 0; r < 9; r++)
#pragma unroll
      for (int cc = 0; cc < 4; cc++) acc[r][cc] = 0.f;
    for (int l = kp * 4; l < kp * 4 + 4; l++) {
#pragma unroll 2
      for (int d4 = 0; d4 < 16; d4++) {
        const int kk = l * 64 + d4 * 4;
        float4 wv[4];
#pragma unroll
        for (int q = 0; q < 4; q++) wv[q] = *(const float4*)(w1 + (size_t)(kk + q) * 128 + j4 * 4);
#pragma unroll
        for (int r = 0; r < 9; r++) {
          const float4 xv = (r < 8) ? ((const float4*)tile)[(16 * r + l) * 16 + d4] : ((const float4*)posl)[l * 16 + d4];
          acc[r][0] += xv.x * wv[0].x + xv.y * wv[1].x + xv.z * wv[2].x + xv.w * wv[3].x;
          acc[r][1] += xv.x * wv[0].y + xv.y * wv[1].y + xv.z * wv[2].y + xv.w * wv[3].y;
          acc[r][2] += xv.x * wv[0].z + xv.y * wv[1].z + xv.z * wv[2].z + xv.w * wv[3].z;
          acc[r][3] += xv.x * wv[0].w + xv.y * wv[1].w + xv.z * wv[2].w + xv.w * wv[3].w;
        }
      }
    }
    __syncthreads();
#pragma unroll
    for (int r = 0; r < 9; r++) *(float4*)(red + (kp * 9 + r) * 128 + j4 * 4) = float4{acc[r][0], acc[r][1], acc[r][2], acc[r][3]};
    __syncthreads();
#pragma unroll
    for (int i = 0; i < 4; i++) {
      int id = tid + 256 * i, r = id >> 7, jj = id & 127;
      float xh = 0.f;
#pragma unroll
      for (int k = 0; k < 8; k++) xh += red[(k * 9 + r) * 128 + jj] + red[(k * 9 + 8) * 128 + jj];
      float u = 0.7978845608028654f * (xh + 0.044715f * xh * xh * xh);
      hid[r * 128 + jj] = 0.5f * xh * (2.f - 2.f / (1.f + __expf(2.f * u)));
    }
    __syncthreads();
    {
      const int r = tid >> 5, d = (tid & 31) * 2;
      float o0 = 0.f, o1 = 0.f;
      for (int jj = 0; jj < 128; jj++) {
        float hv = hid[r * 128 + jj];
        float2 wv = *(const float2*)(w2 + jj * 64 + d);
        o0 += hv * wv.x; o1 += hv * wv.y;
      }
      const int n = g * 8 + r;
      if (n == 1023) { o0 = 0.f; o1 = 0.f; }
      if (which == 0) {
        u16* kh_ = (u16*)(p.ws + OFF_KCH);
        u16* kl_ = (u16*)(p.ws + OFF_KCL);
        *(unsigned*)(kh_ + n * 128 + head * 64 + d) = packh2(o0, o1);
        (void)kl_;
      } else {
        u16* vt = (u16*)(p.ws + OFF_VCT);
        vt[(head * 64 + d) * 1024 + n] = f2bf(o0);
        vt[(head * 64 + d + 1) * 1024 + n] = f2bf(o1);
      }
    }
  }
}

__device__ __forceinline__ void phase2_ut(const Params& p, char* smem) {
  char* ws = p.ws;
  u16* sA = (u16*)smem;
  u16* sB = sA + 128 * LDT;
  const int tid = otid(), lane = tid & 63, wave = tid >> 6, quad = lane >> 4, r16 = lane & 15;
  u16* ut = (u16*)((char*)p.out + OO_UT);
  for (int task = obid(); task < 1024; task += gridDim.x) {
    const int cch = task >> 3, hd = (task >> 1) & 3, dvt = task & 1;
    const u16* vrt = (const u16*)(ws + OFF_VRT) + (size_t)(hd * 256 + dvt * 128) * S_ + cch * 128;
    const u16* krt = (const u16*)(ws + OFF_KRTD) + (size_t)(hd * 128) * S_ + cch * 128;
    f32x4 acc[2][8];
    zero_acc(acc);
    gemm_acc(acc, vrt, S_, krt, S_, 128, sA, sB);
    u16* dst = ut + ((size_t)(cch * 4 + hd) * 256 + dvt * 128) * 128;
#pragma unroll
    for (int mt = 0; mt < 2; mt++)
#pragma unroll
      for (int nt = 0; nt < 8; nt++)
#pragma unroll
        for (int i = 0; i < 4; i++) dst[(wave * 32 + mt * 16 + quad * 4 + i) * 128 + nt * 16 + r16] = f2bf(acc[mt][nt][i]);
  }
}

#define P3_KH 0
#define P3_KL 9216
#define P3_V 18432
#define P3_IMP 27648
#define P3_SEL (27648 + 4 * NG * 2 * 1040)
#define P3_SELN (P3_SEL + 4 * NG * 2 * 64)
#define P3_TASK (P3_SELN + 128)
#define P3T 72
#define NG 2

template <int CTRL>
__device__ __forceinline__ float dpp_f(float a) { return __int_as_float(__builtin_amdgcn_mov_dpp(__float_as_int(a), CTRL, 0xf, 0xf, true)); }
__device__ __forceinline__ float hsum8(float a) {
  a += dpp_f<0xB1>(a);
  a += dpp_f<0x4E>(a);
  a += dpp_f<0x141>(a);
  return a;
}

__device__ __forceinline__ void softmax_pv(f32x4 (&s)[4], int kbase, bool colactive, int tq, int W, const bf16x8 (&vf)[2][4], f32x4 (&o)[4],
                                           float& m_run, float& l_run, int quad) {
  float mx = NEGF;
  bool ok[4][4];
#pragma unroll
  for (int a = 0; a < 4; a++)
#pragma unroll
    for (int i = 0; i < 4; i++) {
      int kpos = kbase + 16 * a + 4 * quad + i;
      ok[a][i] = colactive && (kpos <= tq) && (kpos > tq - W);
      s[a][i] *= 0.125f;
      if (ok[a][i]) mx = fmaxf(mx, s[a][i]);
    }
  mx = fmaxf(mx, __shfl_xor(mx, 16));
  mx = fmaxf(mx, __shfl_xor(mx, 32));
  const float m_new = fmaxf(m_run, mx);
  const float alpha = __expf(m_run - m_new);
  m_run = m_new;
  float ps = 0.f;
#pragma unroll
  for (int a = 0; a < 4; a++)
#pragma unroll
    for (int i = 0; i < 4; i++) {
      float pv = ok[a][i] ? __expf(s[a][i] - m_new) : 0.f;
      s[a][i] = pv;
      ps += pv;
    }
  l_run = l_run * alpha + ps;
#pragma unroll
  for (int dt = 0; dt < 4; dt++)
#pragma unroll
    for (int i = 0; i < 4; i++) o[dt][i] *= alpha;
#pragma unroll
  for (int kk = 0; kk < 2; kk++) {
    union { bf16x8 v; unsigned u[4]; } pf;
    pf.u[0] = pack2(s[2 * kk][0], s[2 * kk][1]);
    pf.u[1] = pack2(s[2 * kk][2], s[2 * kk][3]);
    pf.u[2] = pack2(s[2 * kk + 1][0], s[2 * kk + 1][1]);
    pf.u[3] = pack2(s[2 * kk + 1][2], s[2 * kk + 1][3]);
#pragma unroll
    for (int dt = 0; dt < 4; dt++) o[dt] = __builtin_amdgcn_mfma_f32_16x16x32_bf16(vf[kk][dt], pf.v, o[dt], 0, 0, 0);
  }
}

__device__ __forceinline__ void attn_tile_task(const Params& p, int qt, int kvh, char* smem) {
  char* ws = p.ws;
  const int tid = otid(), lane = tid & 63, wave = tid >> 6, quad = lane >> 4, c = lane & 15, qsel = c >> 3, h = c & 7;
  const int t0 = qt * (8 * NG), tw = t0 + wave * (2 * NG), H = kvh * 8 + h;
  u16* sKh = (u16*)(smem + P3_KH);
  u16* sKl = (u16*)(smem + P3_KL);
  u16* sV = (u16*)(smem + P3_V);
  volatile float* imp = (volatile float*)(smem + P3_IMP + wave * (NG * 2 * 1040));
  volatile int* sel = (volatile int*)(smem + P3_SEL + wave * (NG * 2 * 64));
  volatile int* seln = (volatile int*)(smem + P3_SELN + wave * 32);
  const u16* q_hi = (const u16*)(ws + OFF_QHI);
  const u16* q_lo = (const u16*)(ws + OFF_QLO);
  u16* part = (u16*)(ws + OFF_QLO);
  const float* gates = (const float*)(ws + OFF_GATES);
  const int lr = tid >> 3, lcc = (tid & 7) * 8;

#ifndef CMPREP
#define CMPREP 1
#endif
#pragma unroll 1
  for (int rep = 0; rep < CMPREP; rep++) {
    bf16x8 ql[NG][2];
    int nmaxq[NG];
#pragma unroll
    for (int g = 0; g < NG; g++) {
      const int tq = tw + 2 * g + qsel;
      nmaxq[g] = (tq - 31) >> 4;
#pragma unroll
      for (int ks = 0; ks < 2; ks++) {
        ql[g][ks] = *(const bf16x8*)(q_lo + (size_t)tq * 1024 + H * 64 + ks * 32 + quad * 8);
      }
    }
    const int nmaxt = (t0 + 8 * NG - 32) >> 4;
    const int NCH = nmaxt >= 0 ? (nmaxt >> 6) + 1 : 0;
    const u16* kch = (const u16*)(ws + OFF_KCH) + kvh * 64;
    const u16* kcl = (const u16*)(ws + OFF_KCL) + kvh * 64;
    const u16* vct = (const u16*)(ws + OFF_VCT) + (size_t)(kvh * 64) * 1024;
    float m_l[NG], l_l[NG];
#pragma unroll
    for (int g = 0; g < NG; g++) { m_l[g] = NEGF; l_l[g] = 0.f; }
    u32x4 pk[4], pv[2];
#pragma unroll
    for (int i = 0; i < 2; i++) {
      pk[i] = *(const u32x4*)(kch + (size_t)(lr + 32 * i) * 128 + lcc);
    }
    for (int ch = 0; ch < NCH; ch++) {
      __syncthreads();
#pragma unroll
      for (int i = 0; i < 2; i++) {
        *(u32x4*)(sKh + (lr + 32 * i) * P3T + lcc) = pk[i];
      }
      __syncthreads();
      if (ch + 1 < NCH) {
#pragma unroll
        for (int i = 0; i < 2; i++) {
          pk[i] = *(const u32x4*)(kch + (size_t)(64 * (ch + 1) + lr + 32 * i) * 128 + lcc);
        }
      }
#pragma unroll
      for (int a = 0; a < 4; a++) {
        bf16x8 kh_[2];
#pragma unroll
        for (int ks = 0; ks < 2; ks++) {
          kh_[ks] = *(const bf16x8*)(sKh + (16 * a + c) * P3T + ks * 32 + quad * 8);
        }
        const int nb = 64 * ch + 16 * a + 4 * quad;
#pragma unroll
        for (int g = 0; g < NG; g++) {
          f32x4 s = f32x4{0.f, 0.f, 0.f, 0.f};
#pragma unroll
          for (int ks = 0; ks < 2; ks++) {
            s = mfma16(kh_[ks], ql[g][ks], s);
          }
          float mx = NEGF;
#pragma unroll
          for (int i = 0; i < 4; i++) {
            s[i] *= 0.125f;
            if (nb + i <= nmaxq[g]) mx = fmaxf(mx, s[i]);
          }
          const float m_new = fmaxf(m_l[g], mx);
          float ll = l_l[g] * __expf(m_l[g] - m_new);
#pragma unroll
          for (int i = 0; i < 4; i++)
            if (nb + i <= nmaxq[g]) ll += __expf(s[i] - m_new);
          l_l[g] = ll;
          m_l[g] = m_new;
        }
      }
    }
    float Mx[NG], invL[NG];
#pragma unroll
    for (int g = 0; g < NG; g++) {
      float M = fmaxf(m_l[g], __shfl_xor(m_l[g], 16));
      M = fmaxf(M, __shfl_xor(M, 32));
      float ll = l_l[g] * __expf(m_l[g] - M);
      ll += __shfl_xor(ll, 16);
      ll += __shfl_xor(ll, 32);
      Mx[g] = M;
      invL[g] = (ll > 0.f) ? 1.f / ll : 0.f;
    }
    f32x4 ocmp[NG][4];
    float carry[NG];
#pragma unroll
    for (int g = 0; g < NG; g++) {
      carry[g] = 0.f;
#pragma unroll
      for (int dt = 0; dt < 4; dt++) ocmp[g][dt] = f32x4{0.f, 0.f, 0.f, 0.f};
    }
#pragma unroll
    for (int i = 0; i < 2; i++) {
      pk[i] = *(const u32x4*)(kch + (size_t)(lr + 32 * i) * 128 + lcc);
      pv[i] = *(const u32x4*)(vct + (size_t)(lr + 32 * i) * 1024 + lcc);
    }
    for (int ch = 0; ch < NCH; ch++) {
      __syncthreads();
#pragma unroll
      for (int i = 0; i < 2; i++) {
        *(u32x4*)(sKh + (lr + 32 * i) * P3T + lcc) = pk[i];
        *(u32x4*)(sV + (lr + 32 * i) * P3T + lcc) = pv[i];
      }
      __syncthreads();
      if (ch + 1 < NCH) {
#pragma unroll
        for (int i = 0; i < 2; i++) {
          pk[i] = *(const u32x4*)(kch + (size_t)(64 * (ch + 1) + lr + 32 * i) * 128 + lcc);
          pv[i] = *(const u32x4*)(vct + (size_t)(lr + 32 * i) * 1024 + 64 * (ch + 1) + lcc);
        }
      }
#pragma unroll
      for (int kk = 0; kk < 2; kk++) {
        float pr[NG][2][4];
#pragma unroll
        for (int e = 0; e < 2; e++) {
          const int a = 2 * kk + e;
          bf16x8 kh_[2];
#pragma unroll
          for (int ks = 0; ks < 2; ks++) {
            kh_[ks] = *(const bf16x8*)(sKh + (16 * a + c) * P3T + ks * 32 + quad * 8);
          }
          const int nb = 64 * ch + 16 * a + 4 * quad;
#pragma unroll
          for (int g = 0; g < NG; g++) {
            f32x4 s = f32x4{0.f, 0.f, 0.f, 0.f};
#pragma unroll
            for (int ks = 0; ks < 2; ks++) {
              s = mfma16(kh_[ks], ql[g][ks], s);
            }
#pragma unroll
            for (int i = 0; i < 4; i++) pr[g][e][i] = (nb + i <= nmaxq[g]) ? __expf(s[i] * 0.125f - Mx[g]) * invL[g] : 0.f;
            float av = hsum8(pr[g][e][0] + pr[g][e][1] + pr[g][e][2] + 0.5f * pr[g][e][3]);
            float bv = hsum8(0.5f * pr[g][e][3]);
            const float bs = __shfl(bv, (lane + 48) & 63);
            av += (quad > 0) ? bs : carry[g];
            carry[g] = bs;
            if (h == 0) imp[(2 * g + qsel) * 260 + 16 * ch + 4 * a + quad] = av;
          }
        }
        bf16x8 vf[4];
#pragma unroll
        for (int dt = 0; dt < 4; dt++) {
          union { bf16x8 v; u32x2 u[2]; } t;
          t.u[0] = *(const u32x2*)(sV + (dt * 16 + c) * P3T + 32 * kk + 4 * quad);
          t.u[1] = *(const u32x2*)(sV + (dt * 16 + c) * P3T + 32 * kk + 16 + 4 * quad);
          vf[dt] = t.v;
        }
#pragma unroll
        for (int g = 0; g < NG; g++) {
          union { bf16x8 v; unsigned u[4]; } pf;
          pf.u[0] = pack2(pr[g][0][0], pr[g][0][1]);
          pf.u[1] = pack2(pr[g][0][2], pr[g][0][3]);
          pf.u[2] = pack2(pr[g][1][0], pr[g][1][1]);
          pf.u[3] = pack2(pr[g][1][2], pr[g][1][3]);
#pragma unroll
          for (int dt = 0; dt < 4; dt++) ocmp[g][dt] = __builtin_amdgcn_mfma_f32_16x16x32_bf16(vf[dt], pf.v, ocmp[g][dt], 0, 0, 0);
        }
      }
    }
#pragma unroll
    for (int g = 0; g < NG; g++) {
      const int tq = tw + 2 * g + qsel;
      const float g0 = gates[(size_t)tq * 48 + H * 3 + 0];
#pragma unroll
      for (int dt = 0; dt < 4; dt++) {
        u32x2 v;
        v.x = pack2(g0 * ocmp[g][dt][0], g0 * ocmp[g][dt][1]);
        v.y = pack2(g0 * ocmp[g][dt][2], g0 * ocmp[g][dt][3]);
        *(u32x2*)(part + (size_t)tq * 1024 + H * 64 + dt * 16 + 4 * quad) = v;
      }
    }
  }

#ifndef WINREP
#define WINREP 1
#endif
#pragma unroll 1
  for (int wrep = 0; wrep < WINREP; wrep++) {
    bf16x8 qh[NG][2];
    int tqs[NG];
#pragma unroll
    for (int g = 0; g < NG; g++) {
      tqs[g] = tw + 2 * g + qsel;
#pragma unroll
      for (int ks = 0; ks < 2; ks++) qh[g][ks] = *(const bf16x8*)(q_hi + (size_t)tqs[g] * 1024 + H * 64 + ks * 32 + quad * 8);
    }
    f32x4 ow[NG][4];
    float mw[NG], lw[NG];
#pragma unroll
    for (int g = 0; g < NG; g++) {
      mw[g] = NEGF; lw[g] = 0.f;
#pragma unroll
      for (int dt = 0; dt < 4; dt++) ow[g][dt] = f32x4{0.f, 0.f, 0.f, 0.f};
    }
    const u16* kwb = (const u16*)(ws + OFF_KW) + kvh * 64;
    const u16* vwt = (const u16*)(ws + OFF_VWT) + (size_t)(kvh * 64) * S_;
    int lo = t0 - 511; if (lo < 0) lo = 0;
    const int jlo = lo >> 6, jhi = (t0 + 8 * NG - 1) >> 6;
    u32x4 pk[2], pv[2];
#pragma unroll
    for (int i = 0; i < 2; i++) {
      pk[i] = *(const u32x4*)(kwb + (size_t)(64 * jlo + lr + 32 * i) * 128 + lcc);
      pv[i] = *(const u32x4*)(vwt + (size_t)(lr + 32 * i) * S_ + 64 * jlo + lcc);
    }
    for (int j = jlo; j <= jhi; j++) {
      __syncthreads();
#pragma unroll
      for (int i = 0; i < 2; i++) {
        *(u32x4*)(sKh + (lr + 32 * i) * P3T + lcc) = pk[i];
        *(u32x4*)(sV + (lr + 32 * i) * P3T + lcc) = pv[i];
      }
      __syncthreads();
      if (j + 1 <= jhi) {
#pragma unroll
        for (int i = 0; i < 2; i++) {
          pk[i] = *(const u32x4*)(kwb + (size_t)(64 * (j + 1) + lr + 32 * i) * 128 + lcc);
          pv[i] = *(const u32x4*)(vwt + (size_t)(lr + 32 * i) * S_ + 64 * (j + 1) + lcc);
        }
      }
      bf16x8 kf[4][2], vf[2][4];
#pragma unroll
      for (int a = 0; a < 4; a++)
#pragma unroll
        for (int ks = 0; ks < 2; ks++) kf[a][ks] = *(const bf16x8*)(sKh + (16 * a + c) * P3T + ks * 32 + quad * 8);
#pragma unroll
      for (int kk = 0; kk < 2; kk++)
#pragma unroll
        for (int dt = 0; dt < 4; dt++) {
          union { bf16x8 v; u32x2 u[2]; } t;
          t.u[0] = *(const u32x2*)(sV + (dt * 16 + c) * P3T + 32 * kk + 4 * quad);
          t.u[1] = *(const u32x2*)(sV + (dt * 16 + c) * P3T + 32 * kk + 16 + 4 * quad);
          vf[kk][dt] = t.v;
        }
#pragma unroll
      for (int g = 0; g < NG; g++) {
        f32x4 s[4];
#pragma unroll
        for (int a = 0; a < 4; a++) {
          s[a] = f32x4{0.f, 0.f, 0.f, 0.f};
#pragma unroll
          for (int ks = 0; ks < 2; ks++) s[a] = __builtin_amdgcn_mfma_f32_16x16x32_bf16(kf[a][ks], qh[g][ks], s[a], 0, 0, 0);
        }
        softmax_pv(s, 64 * j, true, tqs[g], 512, vf, ow[g], mw[g], lw[g], quad);
      }
    }
#pragma unroll
    for (int g = 0; g < NG; g++) {
      float L = lw[g] + __shfl_xor(lw[g], 16);
      L += __shfl_xor(L, 32);
      const float g2 = gates[(size_t)tqs[g] * 48 + H * 3 + 2] / fmaxf(L, 1e-30f);
#pragma unroll
      for (int dt = 0; dt < 4; dt++) {
        u16* pp = part + (size_t)tqs[g] * 1024 + H * 64 + dt * 16 + 4 * quad;
        u32x2 v = *(const u32x2*)pp;
        float y0 = __uint_as_float(v.x << 16) + g2 * ow[g][dt][0];
        float y1 = __uint_as_float(v.x & 0xffff0000u) + g2 * ow[g][dt][1];
        float y2 = __uint_as_float(v.y << 16) + g2 * ow[g][dt][2];
        float y3 = __uint_as_float(v.y & 0xffff0000u) + g2 * ow[g][dt][3];
        v.x = pack2(y0, y1); v.y = pack2(y2, y3);
        if (wrep == WINREP - 1 || L == 12345.678f) *(u32x2*)pp = v;
      }
    }
  }

#ifndef TOPKREP
#define TOPKREP 1
#endif
#pragma unroll 1
  for (int trep = 0; trep < TOPKREP; trep++) {
    const unsigned long long lt = (1ull << lane) - 1ull;
    unsigned bitsq[2 * NG][4], thq[2 * NG];
    int Rq[2 * NG];
    bool srch[2 * NG], act[2 * NG];
#pragma unroll
    for (int qi = 0; qi < 2 * NG; qi++) {
      const int cur = (tw + qi) >> 6;
#pragma unroll
      for (int e = 0; e < 4; e++) {
        const int jj = lane + 64 * e;
        const bool forced = (jj == 0) || (jj == cur) || (jj == cur - 1);
        const bool cand = (jj <= cur) && !forced;
        const float iv = imp[qi * 260 + jj];
        bitsq[qi][e] = cand ? __float_as_uint(iv) : 0u;
      }
      const int F = (cur == 0) ? 1 : ((cur == 1) ? 2 : 3);
      Rq[qi] = 16 - F;
      srch[qi] = (cur + 1 - F) > Rq[qi];
      act[qi] = srch[qi];
      thq[qi] = 0u;
    }
    for (int bit = 30; bit >= 0; bit--) {
      bool any = false;
#pragma unroll
      for (int qi = 0; qi < 2 * NG; qi++) {
        if (act[qi]) {
          const unsigned t2 = thq[qi] | (1u << bit);
          int cnt = 0;
#pragma unroll
          for (int e = 0; e < 4; e++) cnt += __popcll(__ballot(bitsq[qi][e] >= t2));
          if (cnt >= Rq[qi]) {
            thq[qi] = t2;
            if (cnt == Rq[qi]) act[qi] = false;
          }
        }
        any = any || act[qi];
      }
      if (!any) break;
    }
#pragma unroll
    for (int qi = 0; qi < 2 * NG; qi++) {
      const int cur = (tw + qi) >> 6;
      bool forced[4], cand[4], selv[4];
#pragma unroll
      for (int e = 0; e < 4; e++) {
        const int jj = lane + 64 * e;
        forced[e] = (jj == 0) || (jj == cur) || (jj == cur - 1);
        cand[e] = (jj <= cur) && !forced[e];
      }
      if (!srch[qi]) {
#pragma unroll
        for (int e = 0; e < 4; e++) selv[e] = forced[e] || cand[e];
      } else {
        const unsigned th = thq[qi];
        int cgt = 0;
#pragma unroll
        for (int e = 0; e < 4; e++) cgt += __popcll(__ballot(cand[e] && bitsq[qi][e] > th));
        const int need = Rq[qi] - cgt;
        int prior = 0;
#pragma unroll
        for (int e = 0; e < 4; e++) {
          const bool eq = cand[e] && bitsq[qi][e] == th;
          const unsigned long long m = __ballot(eq);
          const int rank = prior + __popcll(m & lt);
          selv[e] = forced[e] || (cand[e] && bitsq[qi][e] > th) || (eq && rank < need);
          prior += __popcll(m);
        }
      }
      if (qi & 1) {
#pragma unroll
        for (int e = 0; e < 4; e++) selv[e] = selv[e] && !forced[e];
      }
      int base = 0;
#pragma unroll
      for (int e = 0; e < 4; e++) {
        const unsigned long long m = __ballot(selv[e]);
        if (selv[e]) sel[qi * 16 + base + __popcll(m & lt)] = lane + 64 * e;
        base += __popcll(m);
      }
      if (lane == 0) seln[qi] = base;
    }
  }
  __builtin_amdgcn_wave_barrier();

  {
    const u16* ksb = (const u16*)(ws + OFF_KS) + (size_t)kvh * 256 * 4096 + lane * 8;
    const u16* vst = (const u16*)(ws + OFF_VST) + (size_t)kvh * 256 * 4096 + lane * 8;
    u16* ya = (u16*)(ws + OFF_QHI);
    const int curb = tw >> 6;
    bf16x8 qh[NG][2];
    f32x4 os[NG][4];
    float ms[NG], ls[NG];
    int tqs[NG], n0[NG], ntot[NG];
    u32x4 kn[NG][4][2], vn[NG][2][4];
    int jn[NG];
    int nmax = 0;
#pragma unroll
    for (int g = 0; g < NG; g++) {
      tqs[g] = tw + 2 * g + qsel;
      ms[g] = NEGF; ls[g] = 0.f;
#pragma unroll
      for (int ks = 0; ks < 2; ks++) qh[g][ks] = *(const bf16x8*)(q_hi + (size_t)tqs[g] * 1024 + H * 64 + ks * 32 + quad * 8);
#pragma unroll
      for (int dt = 0; dt < 4; dt++) os[g][dt] = f32x4{0.f, 0.f, 0.f, 0.f};
      n0[g] = __builtin_amdgcn_readfirstlane(seln[2 * g]);
      ntot[g] = n0[g] + __builtin_amdgcn_readfirstlane(seln[2 * g + 1]);
      nmax = ntot[g] > nmax ? ntot[g] : nmax;
      jn[g] = __builtin_amdgcn_readfirstlane(sel[(2 * g) * 16]);
      const u16* kp = ksb + (size_t)jn[g] * 4096;
      const u16* vp = vst + (size_t)jn[g] * 4096;
#pragma unroll
      for (int a = 0; a < 4; a++)
#pragma unroll
        for (int ks = 0; ks < 2; ks++) kn[g][a][ks] = *(const u32x4*)(kp + (a * 2 + ks) * 512);
#pragma unroll
      for (int kk = 0; kk < 2; kk++)
#pragma unroll
        for (int dt = 0; dt < 4; dt++) vn[g][kk][dt] = *(const u32x4*)(vp + (kk * 4 + dt) * 512);
    }
    for (int idx = 0; idx < nmax; idx++) {
#pragma unroll
      for (int g = 0; g < NG; g++) {
        const int jthis = jn[g];
        const bool valid = idx < ntot[g];
        const int qs = (idx < n0[g]) ? 0 : 1;
        f32x4 sc[4];
        bf16x8 vf[2][4];
#pragma unroll
        for (int a = 0; a < 4; a++) {
          sc[a] = f32x4{0.f, 0.f, 0.f, 0.f};
#pragma unroll
          for (int ks = 0; ks < 2; ks++) {
            union { bf16x8 v; u32x4 u; } t; t.u = kn[g][a][ks];
            sc[a] = __builtin_amdgcn_mfma_f32_16x16x32_bf16(t.v, qh[g][ks], sc[a], 0, 0, 0);
          }
        }
#pragma unroll
        for (int kk = 0; kk < 2; kk++)
#pragma unroll
          for (int dt = 0; dt < 4; dt++) { union { bf16x8 v; u32x4 u; } t; t.u = vn[g][kk][dt]; vf[kk][dt] = t.v; }
        const bool forced_blk = (jthis == 0) || (jthis == curb) || (jthis == curb - 1);
        softmax_pv(sc, 64 * jthis, valid && (forced_blk || (qsel == qs)), tqs[g], 1 << 30, vf, os[g], ms[g], ls[g], quad);
        int nx = idx + 1;
        nx = nx < ntot[g] ? nx : ntot[g] - 1;
        const int j = __builtin_amdgcn_readfirstlane((nx < n0[g]) ? sel[(2 * g) * 16 + nx] : sel[(2 * g + 1) * 16 + (nx - n0[g])]);
        jn[g] = j;
        const u16* kp = ksb + (size_t)j * 4096;
        const u16* vp = vst + (size_t)j * 4096;
#pragma unroll
        for (int a = 0; a < 4; a++)
#pragma unroll
          for (int ks = 0; ks < 2; ks++) kn[g][a][ks] = *(const u32x4*)(kp + (a * 2 + ks) * 512);
#pragma unroll
        for (int kk = 0; kk < 2; kk++)
#pragma unroll
          for (int dt = 0; dt < 4; dt++) vn[g][kk][dt] = *(const u32x4*)(vp + (kk * 4 + dt) * 512);
      }
    }
#pragma unroll
    for (int g = 0; g < NG; g++) {
      float L = ls[g] + __shfl_xor(ls[g], 16);
      L += __shfl_xor(L, 32);
      const float g1 = gates[(size_t)tqs[g] * 48 + H * 3 + 1] / fmaxf(L, 1e-30f);
#pragma unroll
      for (int dt = 0; dt < 4; dt++) {
        const u32x2 v = *(const u32x2*)(part + (size_t)tqs[g] * 1024 + H * 64 + dt * 16 + 4 * quad);
        float y0 = __uint_as_float(v.x << 16) + g1 * os[g][dt][0];
        float y1 = __uint_as_float(v.x & 0xffff0000u) + g1 * os[g][dt][1];
        float y2 = __uint_as_float(v.y << 16) + g1 * os[g][dt][2];
        float y3 = __uint_as_float(v.y & 0xffff0000u) + g1 * os[g][dt][3];
        u32x2 o;
        o.x = pack2(y0, y1); o.y = pack2(y2, y3);
        *(u32x2*)(ya + (size_t)tqs[g] * 1024 + H * 64 + dt * 16 + 4 * quad) = o;
      }
    }
  }
}

__device__ __forceinline__ void gr_tile(const Params& p, int t, char* smem) {
  char* ws = p.ws;
  const int tid = otid(), lane = tid & 63, wave = tid >> 6, quad = lane >> 4, r16 = lane & 15;
  const int m0 = (t >> 3) * 128, nti = t & 7;
  const u16* hh = (const u16*)(ws + OFF_HH);
  const u16* w1 = (const u16*)((char*)p.out + OO_W1T);
  u16* dst = (u16*)(ws + OFF_G);
  f32x4 acc[2][8];
  zero_acc(acc);
  gemm_acc(acc, hh + (size_t)m0 * 1024, 1024, w1 + (size_t)(3968 + nti * 128) * 1024, 1024, 1024, (u16*)smem, nullptr);
#pragma unroll
  for (int mt = 0; mt < 2; mt++)
#pragma unroll
    for (int nt = 0; nt < 8; nt++)
#pragma unroll
      for (int i = 0; i < 4; i++)
        dst[(size_t)(m0 + wave * 32 + mt * 16 + quad * 4 + i) * 1024 + nti * 128 + nt * 16 + r16] = f2bf(siluf_(acc[mt][nt][i]));
}

__device__ __forceinline__ void phase3(const Params& p, char* smem) {
  char* ws = p.ws;
  const int tid = otid(), lane = tid & 63, wave = tid >> 6, quad = lane >> 4, r16 = lane & 15;
  const int bid = obid();
  if (bid < 64) {
    u16* ut = (u16*)((char*)p.out + OO_UT);
    u16* rtb = ut;
    const int e0 = (bid * 256 + tid) * 8;
    const float dc = __expf(logg_of(e0 >> 15) * 128.f);
    float r[8];
#pragma unroll
    for (int k = 0; k < 8; k++) r[k] = 0.f;
#pragma unroll 8
    for (int cch = 0; cch < 128; cch++) {
      const u32x4 u = *(const u32x4*)(ut + (size_t)cch * 131072 + e0);
      u32x4 o;
      o.x = pack2(r[0], r[1]); o.y = pack2(r[2], r[3]); o.z = pack2(r[4], r[5]); o.w = pack2(r[6], r[7]);
      *(u32x4*)(rtb + (size_t)cch * 131072 + e0) = o;
      r[0] = r[0] * dc + __uint_as_float(u.x << 16); r[1] = r[1] * dc + __uint_as_float(u.x & 0xffff0000u);
      r[2] = r[2] * dc + __uint_as_float(u.y << 16); r[3] = r[3] * dc + __uint_as_float(u.y & 0xffff0000u);
      r[4] = r[4] * dc + __uint_as_float(u.z << 16); r[5] = r[5] * dc + __uint_as_float(u.z & 0xffff0000u);
      r[6] = r[6] * dc + __uint_as_float(u.w << 16); r[7] = r[7] * dc + __uint_as_float(u.w & 0xffff0000u);
    }
  }
  unsigned* ctr = (unsigned*)(ws + OFF_CTR);
  volatile unsigned* stask = (volatile unsigned*)(smem + P3_TASK);
  {
  for (int pass = 0; pass < 2; pass++) {
    const int kvh = (bid & 1) ^ pass;
    while (true) {
      __syncthreads();
      if (tid == 0) *stask = atomicAdd(ctr + kvh, 1u);
      __syncthreads();
      const unsigned t = *stask;
      if (t >= (unsigned)(S_ / (8 * NG))) break;
      attn_tile_task(p, S_ / (8 * NG) - 1 - (int)t, kvh, smem);
    }
  }
  }
}

__device__ __forceinline__ void phase4(const Params& p, char* smem) {
  char* ws = p.ws;
  u16* sA = (u16*)smem;
  u16* sB = sA + 128 * LDT;
  const u16* hh = (const u16*)(ws + OFF_HH);
  const u16* w1 = (const u16*)((char*)p.out + OO_W1T);
  const u16* qr = (const u16*)(ws + OFF_QR);
  const u16* kr = (const u16*)(ws + OFF_KR);
  const u16* vrt = (const u16*)(ws + OFF_VRT);
  const u16* rtb = (const u16*)((char*)p.out + OO_UT);
  u16* pbuf = (u16*)(ws + OFF_PBUF);
  u16* yr = (u16*)(ws + OFF_YR);
  for (int task = obid(); task < 512; task += gridDim.x) {
    const int cch = task >> 2, hd = task & 3, m0 = cch * 128;
    const int tid = otid(), lane = tid & 63, wave = tid >> 6, quad = lane >> 4, r16 = lane & 15;
    const float logg = logg_of(hd);
    const int rloc = wave * 32 + quad * 4;
    const u16* gbuf = (const u16*)(ws + OFF_G);
    u16* pb = pbuf + (size_t)task * 16384;
    {
      f32x4 acc[2][8];
      zero_acc(acc);
      gemm_acc(acc, qr + (size_t)m0 * 512 + hd * 128, 512, kr + (size_t)m0 * 512 + hd * 128, 512, 128, sA, sB);
      float cf[8];
#pragma unroll
      for (int nt = 0; nt < 8; nt++) cf[nt] = __expf(-logg * (float)(nt * 16 + r16));
#pragma unroll
      for (int mt = 0; mt < 2; mt++)
#pragma unroll
        for (int i = 0; i < 4; i++) {
          const int ii = rloc + mt * 16 + i;
          const float rf = __expf(logg * (float)ii);
#pragma unroll
          for (int nt = 0; nt < 8; nt++) {
            const int jj = nt * 16 + r16;
            float v = (ii >= jj) ? acc[mt][nt][i] * rf * cf[nt] : 0.f;
            pb[ii * 128 + jj] = f2bf(v);
          }
        }
    }
    asm volatile("s_waitcnt vmcnt(0)" ::: "memory");
    __syncthreads();
    float s1[2][4], s2[2][4];
#pragma unroll
    for (int mt = 0; mt < 2; mt++)
#pragma unroll
      for (int i = 0; i < 4; i++) { s1[mt][i] = 0.f; s2[mt][i] = 0.f; }
#pragma unroll 1
    for (int dvt = 0; dvt < 2; dvt++) {
      f32x4 ao[2][8];
      zero_acc(ao);
      gemm_acc(ao, qr + (size_t)m0 * 512 + hd * 128, 512, rtb + ((size_t)(cch * 4 + hd) * 256 + dvt * 128) * 128, 128, 128, sA, sB);
#pragma unroll
      for (int mt = 0; mt < 2; mt++)
#pragma unroll
        for (int i = 0; i < 4; i++) {
          float dq = __expf(logg * (float)(rloc + mt * 16 + i + 1));
#pragma unroll
          for (int nt = 0; nt < 8; nt++) ao[mt][nt][i] *= dq;
        }
      gemm_acc(ao, pb, 128, vrt + (size_t)(hd * 256 + dvt * 128) * S_ + m0, S_, 128, sA, sB);
#pragma unroll
      for (int mt = 0; mt < 2; mt++)
#pragma unroll
        for (int i = 0; i < 4; i++)
#pragma unroll
          for (int nt = 0; nt < 8; nt++) {
            const float v = ao[mt][nt][i];
            s1[mt][i] += v; s2[mt][i] += v * v;
            yr[(size_t)(m0 + rloc + mt * 16 + i) * 1024 + hd * 256 + dvt * 128 + nt * 16 + r16] = f2bf(v);
          }
    }
#pragma unroll
    for (int mt = 0; mt < 2; mt++)
#pragma unroll
      for (int i = 0; i < 4; i++) {
        float a = s1[mt][i], b = s2[mt][i];
        a += __shfl_xor(a, 1); a += __shfl_xor(a, 2); a += __shfl_xor(a, 4); a += __shfl_xor(a, 8);
        b += __shfl_xor(b, 1); b += __shfl_xor(b, 2); b += __shfl_xor(b, 4); b += __shfl_xor(b, 8);
        const float mean = a * (1.f / 256.f);
        const float var = fmaxf(b * (1.f / 256.f) - mean * mean, 0.f);
        const float rstd = rsqrtf(var + 1e-6f);
        const size_t row = (size_t)(m0 + rloc + mt * 16 + i);
#pragma unroll
        for (int dvt = 0; dvt < 2; dvt++)
#pragma unroll
          for (int nt = 0; nt < 8; nt++) {
            const int cg = hd * 256 + dvt * 128 + nt * 16 + r16;
            const float gs = bf2f(gbuf[row * 1024 + cg]);
            u16* q = yr + row * 1024 + hd * 256 + dvt * 128 + nt * 16 + r16;
            *q = f2bf(gs * (bf2f(*q) - mean) * rstd);
          }
      }
  }
}

__device__ __forceinline__ void phase5(const Params& p, char* smem) {
  char* ws = p.ws;
  u16* sA = (u16*)smem;
  u16* sB = sA + 128 * LDT;
  const int tid = otid(), lane = tid & 63, wave = tid >> 6, quad = lane >> 4, r16 = lane & 15;
  const u16* hh = (const u16*)(ws + OFF_HH);
  const u16* w1 = (const u16*)((char*)p.out + OO_W1T);
  const u16* ya = (const u16*)(ws + OFF_QHI);
  const u16* yr = (const u16*)(ws + OFF_YR);
  const u16* wba = (const u16*)(ws + OFF_WBA);
  const u16* wbb = (const u16*)(ws + OFF_WBB);
  float* mf = (float*)(ws + OFF_MERGEDF);
  u16* mg = (u16*)(ws + OFF_MERGED);
  for (int it = 0;; it++) {
    int mtile, nti; bool valid;
    if (!next_tile(it, 128, 8, 8, 8, mtile, nti, valid)) break;
    if (!valid) continue;
    const int m0 = mtile * 128, n0 = nti * 128;
    const int rbase = m0 + wave * 32 + quad * 4;
    f32x4 acc[2][8];
    zero_acc(acc);
    gemm_acc(acc, hh + (size_t)m0 * 1024, 1024, w1 + (size_t)(6016 + n0) * 1024, 1024, 1024, sA, sB);
#pragma unroll
    for (int mt = 0; mt < 2; mt++)
#pragma unroll
      for (int nt = 0; nt < 8; nt++)
#pragma unroll
        for (int i = 0; i < 4; i++) mf[(size_t)(rbase + mt * 16 + i) * 1024 + n0 + nt * 16 + r16] = sigmoidf_(acc[mt][nt][i]);
    zero_acc(acc);
    gemm_acc(acc, yr + (size_t)m0 * 1024, 1024, wbb + (size_t)n0 * 1024, 1024, 1024, sA, sB);
#pragma unroll
    for (int mt = 0; mt < 2; mt++)
#pragma unroll
      for (int nt = 0; nt < 8; nt++)
#pragma unroll
        for (int i = 0; i < 4; i++) {
          const size_t idx = (size_t)(rbase + mt * 16 + i) * 1024 + n0 + nt * 16 + r16;
          mf[idx] = mf[idx] * acc[mt][nt][i];
        }
    zero_acc(acc);
    gemm_acc(acc, hh + (size_t)m0 * 1024, 1024, w1 + (size_t)(4992 + n0) * 1024, 1024, 1024, sA, sB);
#pragma unroll
    for (int mt = 0; mt < 2; mt++)
#pragma unroll
      for (int nt = 0; nt < 8; nt++)
#pragma unroll
        for (int i = 0; i < 4; i++) mg[(size_t)(rbase + mt * 16 + i) * 1024 + n0 + nt * 16 + r16] = f2bf(sigmoidf_(acc[mt][nt][i]));
    zero_acc(acc);
    gemm_acc(acc, ya + (size_t)m0 * 1024, 1024, wba + (size_t)n0 * 1024, 1024, 1024, sA, sB);
#pragma unroll
    for (int mt = 0; mt < 2; mt++)
#pragma unroll
      for (int nt = 0; nt < 8; nt++)
#pragma unroll
        for (int i = 0; i < 4; i++) {
          const size_t idx = (size_t)(rbase + mt * 16 + i) * 1024 + n0 + nt * 16 + r16;
          mg[idx] = f2bf(bf2f(mg[idx]) * acc[mt][nt][i] + mf[idx]);
        }
  }
}

__device__ __forceinline__ void phase_proj(const Params& p, char* smem, const u16* A, int K, const u16* Wt, float* dst, float* ssq) {
  u16* sA = (u16*)smem;
  for (int it = 0;; it++) {
    int mtile, npair; bool valid;
    if (!next_tile(it, 128, 4, 16, 4, mtile, npair, valid)) break;
    if (!valid) continue;
    const int tid = otid(), lane = tid & 63, wave = tid >> 6, quad = lane >> 4, r16 = lane & 15;
    const int m0 = mtile * 128, n0 = npair * 256;
    const int rbase = m0 + wave * 32 + quad * 4;
    f32x4 acc[2][16];
#pragma unroll
    for (int mt = 0; mt < 2; mt++)
#pragma unroll
      for (int nt = 0; nt < 16; nt++) acc[mt][nt] = f32x4{0.f, 0.f, 0.f, 0.f};
    gemm_acc_wide(acc, A + (size_t)m0 * K, K, Wt + (size_t)n0 * K, K, K, sA);
#pragma unroll
    for (int mt = 0; mt < 2; mt++)
#pragma unroll
      for (int i = 0; i < 4; i++) {
        float sq = 0.f;
#pragma unroll
        for (int nt = 0; nt < 16; nt++) {
          float v = acc[mt][nt][i];
          dst[(size_t)(rbase + mt * 16 + i) * 1024 + n0 + nt * 16 + r16] = v;
          sq += v * v;
        }
        sq += __shfl_xor(sq, 1); sq += __shfl_xor(sq, 2); sq += __shfl_xor(sq, 4); sq += __shfl_xor(sq, 8);
        if (r16 == 0) { ssq[(size_t)(rbase + mt * 16 + i) * 8 + 2 * npair] = sq; ssq[(size_t)(rbase + mt * 16 + i) * 8 + 2 * npair + 1] = 0.f; }
      }
  }
}

__device__ __forceinline__ void phase7(const Params& p) {
  char* ws = p.ws;
  const int lane = otid() & 63, wave = otid() >> 6;
  const int gw = obid() * 4 + wave, nw = gridDim.x * 4;
  const float* mix = (const float*)(ws + OFF_MIX);
  const float* ssq = (const float*)(ws + OFF_SSQ1);
  u16* h2 = (u16*)(ws + OFF_H2);
  for (int row0 = gw * 4; row0 < S_; row0 += nw * 4) {
    f32x4 xv[4][4], mv[4][4], g[4];
    float rs[4], s2[4];
#pragma unroll
    for (int r = 0; r < 4; r++)
#pragma unroll
      for (int i = 0; i < 4; i++) {
        xv[r][i] = ((const f32x4*)(p.x + (size_t)(row0 + r) * 1024))[lane + 64 * i];
        mv[r][i] = ((const f32x4*)(mix + (size_t)(row0 + r) * 1024))[lane + 64 * i];
      }
#pragma unroll
    for (int i = 0; i < 4; i++) g[i] = ((const f32x4*)p.g_post_mix)[lane + 64 * i];
#pragma unroll
    for (int r = 0; r < 4; r++) {
      float ss = 0.f;
#pragma unroll
      for (int i = 0; i < 8; i++) ss += ssq[(size_t)(row0 + r) * 8 + i];
      rs[r] = rsqrtf(ss * (1.f / 1024.f) + 1e-6f);
    }
#pragma unroll
    for (int r = 0; r < 4; r++) {
      s2[r] = 0.f;
#pragma unroll
      for (int i = 0; i < 4; i++) {
        f32x4 v = xv[r][i] + mv[r][i] * g[i] * rs[r];
        xv[r][i] = v;
        s2[r] += v[0] * v[0] + v[1] * v[1] + v[2] * v[2] + v[3] * v[3];
        ((f32x4*)(p.out + (size_t)(row0 + r) * 1024))[lane + 64 * i] = v;
      }
    }
#pragma unroll
    for (int o = 32; o >= 1; o >>= 1)
#pragma unroll
      for (int r = 0; r < 4; r++) s2[r] += __shfl_xor(s2[r], o);
#pragma unroll
    for (int i = 0; i < 4; i++) g[i] = ((const f32x4*)p.g_pre_ffn)[lane + 64 * i];
#pragma unroll
    for (int r = 0; r < 4; r++) {
      const float rs2 = rsqrtf(s2[r] * (1.f / 1024.f) + 1e-6f);
#pragma unroll
      for (int i = 0; i < 4; i++) {
        const f32x4 v = xv[r][i] * g[i] * rs2;
        u32x2 H;
        H.x = pack2(v[0], v[1]); H.y = pack2(v[2], v[3]);
        *(u32x2*)(h2 + (size_t)(row0 + r) * 1024 + (lane + 64 * i) * 4) = H;
      }
    }
  }
}

__device__ __forceinline__ void phase8(const Params& p, char* smem) {
  char* ws = p.ws;
  u16* sA = (u16*)smem;
  u16* sB = sA + 128 * LDT;
  const int tid = otid(), lane = tid & 63, wave = tid >> 6, quad = lane >> 4, r16 = lane & 15;
  const u16* h2 = (const u16*)(ws + OFF_H2);
  const u16* wgu = (const u16*)(ws + OFF_WGU);
  u16* act = (u16*)(ws + OFF_ACT);
  for (int it = 0;; it++) {
    int mtile, nti; bool valid;
    if (!next_tile(it, 128, 44, 16, 4, mtile, nti, valid)) break;
    if (!valid) continue;
    const int m0 = mtile * 128;
    const int rbase = m0 + wave * 32 + quad * 4;
    f32x4 acc[2][8];
    zero_acc(acc);
    gemm_acc(acc, h2 + (size_t)m0 * 1024, 1024, wgu + (size_t)(nti * 128) * 1024, 1024, 1024, sA, sB);
#pragma unroll
    for (int mt = 0; mt < 2; mt++)
#pragma unroll
      for (int nt = 0; nt < 4; nt++)
#pragma unroll
        for (int i = 0; i < 4; i++)
          act[(size_t)(rbase + mt * 16 + i) * 2816 + nti * 64 + nt * 16 + r16] = f2bf(siluf_(acc[mt][nt][i]) * acc[mt][nt + 4][i]);
  }
}

__device__ __forceinline__ void phase10(const Params& p) {
  char* ws = p.ws;
  const int lane = otid() & 63, wave = otid() >> 6;
  const int gw = obid() * 4 + wave, nw = gridDim.x * 4;
  const float* f = (const float*)(ws + OFF_F);
  const float* ssq = (const float*)(ws + OFF_SSQ2);
  for (int row0 = gw * 4; row0 < S_; row0 += nw * 4) {
    f32x4 xv[4][4], fv[4][4], g[4];
    float rs[4];
#pragma unroll
    for (int r = 0; r < 4; r++)
#pragma unroll
      for (int i = 0; i < 4; i++) {
        xv[r][i] = ((const f32x4*)(p.out + (size_t)(row0 + r) * 1024))[lane + 64 * i];
        fv[r][i] = ((const f32x4*)(f + (size_t)(row0 + r) * 1024))[lane + 64 * i];
      }
#pragma unroll
    for (int i = 0; i < 4; i++) g[i] = ((const f32x4*)p.g_post_ffn)[lane + 64 * i];
#pragma unroll
    for (int r = 0; r < 4; r++) {
      float ss = 0.f;
#pragma unroll
      for (int i = 0; i < 8; i++) ss += ssq[(size_t)(row0 + r) * 8 + i];
      rs[r] = rsqrtf(ss * (1.f / 1024.f) + 1e-6f);
    }
#pragma unroll
    for (int r = 0; r < 4; r++)
#pragma unroll
      for (int i = 0; i < 4; i++) ((f32x4*)(p.out + (size_t)(row0 + r) * 1024))[lane + 64 * i] = xv[r][i] + fv[r][i] * g[i] * rs[r];
  }
}

__device__ __forceinline__ void run_phase(const Params& p, int ph, char* smem) {
  switch (ph) {
    case 0: phase0(p, smem); break;
    case 1: phase1(p, smem); break;
    case 2: phase2(p, smem); phase2_ut(p, smem); for (int t = obid(); t < 1024; t += gridDim.x) gr_tile(p, t, smem); break;
    case 3: phase3(p, smem); break;
    case 4: phase4(p, smem); break;
    case 5: phase5(p, smem); break;
    case 6: phase_proj(p, smem, (const u16*)(p.ws + OFF_MERGED), 1024, (const u16*)(p.ws + OFF_WOUT), (float*)(p.ws + OFF_MIX), (float*)(p.ws + OFF_SSQ1)); break;
    case 7: phase7(p); break;
    case 8: phase8(p, smem); break;
    case 9: phase_proj(p, smem, (const u16*)(p.ws + OFF_ACT), 2816, (const u16*)(p.ws + OFF_WD), (float*)(p.ws + OFF_F), (float*)(p.ws + OFF_SSQ2)); break;
    case 10: phase10(p); break;
  }
}

#define NPHASE 11

#if ONE_LAUNCH
#define XB_XCNT(j) (64 * (j))
#define XB_XSUB(j) (1024 + 64 * (j))
#define XB_XGEN(j) (2048 + 64 * (j))
#define XB_TOP 3072
#define XB_TOPGEN 3136
#define XB_WORDS 3200
__device__ __forceinline__ unsigned bar_ld(unsigned* p) { return __hip_atomic_load(p, __ATOMIC_RELAXED, __HIP_MEMORY_SCOPE_AGENT); }
__device__ __forceinline__ unsigned bar_add(unsigned* p) { return __hip_atomic_fetch_add(p, 1u, __ATOMIC_RELAXED, __HIP_MEMORY_SCOPE_AGENT); }
#define BAR_SPIN(cond) do { unsigned sp_ = 0; while (cond) { __builtin_amdgcn_s_sleep(1); if (++sp_ > (1u << 22)) break; } } while (0)
__device__ __forceinline__ unsigned xcc_id() { return (unsigned)__builtin_amdgcn_s_getreg((3 << 11) | 20) & 0xFu; }
__device__ __forceinline__ void fast_grid_barrier(unsigned* bar, unsigned x, volatile unsigned* st) {
  asm volatile("s_waitcnt vmcnt(0)" ::: "memory");
  __syncthreads();
  if (threadIdx.x == 0) {
    __builtin_amdgcn_s_waitcnt(0);
    unsigned nloc = st[0], nx = st[1];
    if (nloc == 0u) {
      const unsigned G = gridDim.x;
      unsigned sp = 0u;
      for (;;) {
        unsigned sum = 0u, cnt = 0u, mine = 0u;
#pragma unroll
        for (unsigned j = 0; j < 16; ++j) { const unsigned c = bar_ld(&bar[XB_XCNT(j)]); sum += c; cnt += (c > 0u) ? 1u : 0u; mine = (j == x) ? c : mine; }
        nloc = mine > 0u ? mine : 1u; nx = cnt > 0u ? cnt : 1u;
        if (sum == G) break;
        __builtin_amdgcn_s_sleep(1);
        if (++sp > (1u << 22)) break;
      }
      st[0] = nloc; st[1] = nx;
    }
    const unsigned old = bar_add(&bar[XB_XSUB(x)]);
    const unsigned gen = old / nloc;
    if (old + 1u == (gen + 1u) * nloc) {
      __builtin_amdgcn_fence(__ATOMIC_RELEASE, "agent");
      asm volatile("s_waitcnt vmcnt(0)" ::: "memory");
      const unsigned og = bar_add(&bar[XB_TOP]);
      const unsigned tg = og / nx;
      if (og + 1u == (tg + 1u) * nx) bar_add(&bar[XB_TOPGEN]);
      else BAR_SPIN(bar_ld(&bar[XB_TOPGEN]) == tg);
      __builtin_amdgcn_fence(__ATOMIC_ACQUIRE, "agent");
      bar_add(&bar[XB_XGEN(x)]);
      asm volatile("s_waitcnt vmcnt(0)" ::: "memory");
    } else {
      BAR_SPIN(bar_ld(&bar[XB_XGEN(x)]) == gen);
      __builtin_amdgcn_fence(__ATOMIC_ACQUIRE, "agent");
      asm volatile("s_waitcnt vmcnt(0)" ::: "memory");
    }
  }
  __syncthreads();
}

__global__ void __launch_bounds__(256, 2) mega_kernel(Params p) {
  extern __shared__ __attribute__((aligned(16))) char smem[];
  cg::grid_group grid = cg::this_grid();
#ifndef REPMASK
#define REPMASK 0
#endif
  if (threadIdx.x == 0) {
    volatile unsigned* bst = (volatile unsigned*)(smem + 73728);
    bst[0] = 0u; bst[1] = 0u;
    bar_add((unsigned*)(p.ws + OFF_BAR) + XB_XCNT(xcc_id()));
  }
  __syncthreads();
  for (int ph = 0; ph < NPHASE; ph++) {
    run_phase(p, ph, smem);
    if ((REPMASK >> ph) & 1) { grid.sync(); run_phase(p, ph, smem); }
    if (ph + 1 < NPHASE) fast_grid_barrier((unsigned*)(p.ws + OFF_BAR), xcc_id(), (volatile unsigned*)(smem + 73728));
    if (p.ws == nullptr) grid.sync();
  }
}

#else
template <int PH>
__global__ void __launch_bounds__(256, 2) phase_kernel(Params p) {
  extern __shared__ __attribute__((aligned(16))) char smem[];
  run_phase(p, PH, smem);
}

#endif

extern "C" void kernel_launch(void* const* d_in, const int* in_sizes, int n_in, void* d_out, int out_size, void* d_ws, size_t ws_size,
                              hipStream_t stream) {
  Params p{};
  p.x = (const float*)d_in[0]; p.g_pre_mix = (const float*)d_in[1]; p.w_in = (const float*)d_in[2];
  p.cpk = (const float*)d_in[3]; p.cw1k = (const float*)d_in[4]; p.cw2k = (const float*)d_in[5];
  p.cpv = (const float*)d_in[6]; p.cw1v = (const float*)d_in[7]; p.cw2v = (const float*)d_in[8];
  p.wba = (const float*)d_in[9]; p.wbb = (const float*)d_in[10]; p.wout = (const float*)d_in[11];
  p.g_post_mix = (const float*)d_in[12]; p.g_pre_ffn = (const float*)d_in[13];
  p.wg = (const float*)d_in[14]; p.wu = (const float*)d_in[15]; p.wd = (const float*)d_in[16]; p.g_post_ffn = (const float*)d_in[17];
  p.out = (float*)d_out; p.ws = (char*)d_ws;
#if ONE_LAUNCH
  static int grid_blocks = 0;
  if (!grid_blocks) {
    int dev = 0, cus = 0, per_cu = 0;
    hipGetDevice(&dev);
    hipDeviceGetAttribute(&cus, hipDeviceAttributeMultiprocessorCount, dev);
    hipFuncSetAttribute((const void*)mega_kernel, hipFuncAttributeMaxDynamicSharedMemorySize, SMEM_BYTES);
    hipOccupancyMaxActiveBlocksPerMultiprocessor(&per_cu, mega_kernel, 256, SMEM_BYTES);
    if (per_cu > 2) per_cu = 2;
    if (per_cu < 1) per_cu = 1;
    grid_blocks = cus * per_cu;
  }
  hipMemsetAsync((char*)d_ws + OFF_CTR, 0, 4096 + 4 * XB_WORDS, stream);
  void* args[] = {&p};
  hipError_t e = hipLaunchCooperativeKernel((void*)mega_kernel, dim3(grid_blocks), dim3(256), args, SMEM_BYTES, stream);
  if (e != hipSuccess) fprintf(stderr, "cooperative launch failed: %s (grid %d)\n", hipGetErrorString(e), grid_blocks);
#else
  hipLaunchKernelGGL(phase_kernel<0>, dim3(512), dim3(256), SMEM_BYTES, stream, p);
  hipLaunchKernelGGL(phase_kernel<1>, dim3(512), dim3(256), SMEM_BYTES, stream, p);
  hipLaunchKernelGGL(phase_kernel<2>, dim3(512), dim3(256), SMEM_BYTES, stream, p);
  hipLaunchKernelGGL(phase_kernel<3>, dim3(512), dim3(256), SMEM_BYTES, stream, p);
  hipLaunchKernelGGL(phase_kernel<4>, dim3(512), dim3(256), SMEM_BYTES, stream, p);
  hipLaunchKernelGGL(phase_kernel<5>, dim3(512), dim3(256), SMEM_BYTES, stream, p);
  hipLaunchKernelGGL(phase_kernel<6>, dim3(512), dim3(256), SMEM_BYTES, stream, p);
  hipLaunchKernelGGL(phase_kernel<7>, dim3(512), dim3(256), SMEM_BYTES, stream, p);
  hipLaunchKernelGGL(phase_kernel<8>, dim3(512), dim3(256), SMEM_BYTES, stream, p);
  hipLaunchKernelGGL(phase_kernel<9>, dim3(512), dim3(256), SMEM_BYTES, stream, p);
  hipLaunchKernelGGL(phase_kernel<10>, dim3(512), dim3(256), SMEM_BYTES, stream, p);
#endif
}
```

```cpp
#include <hip/hip_runtime.h>
#include <hip/hip_bf16.h>
#include <hip/hip_cooperative_groups.h>
#include <cstdio>
namespace cg = cooperative_groups;

#ifndef ONE_LAUNCH
#define ONE_LAUNCH 1
#endif

typedef unsigned short u16;
using bf16x8 = __attribute__((ext_vector_type(8))) short;
using f32x4 = __attribute__((ext_vector_type(4))) float;
using u32x4 = __attribute__((ext_vector_type(4))) unsigned;
using u32x2 = __attribute__((ext_vector_type(2))) unsigned;
using f16x8 = __attribute__((ext_vector_type(8))) _Float16;

#define S_ 16384
#define NEGF (-1e30f)
#define BIGF (1e9f)

struct Params {
  const float *x, *g_pre_mix, *w_in, *cpk, *cw1k, *cw2k, *cpv, *cw1v, *cw2v, *wba, *wbb, *wout, *g_post_mix, *g_pre_ffn, *wg, *wu, *wd, *g_post_ffn;
  float* out;
  char* ws;
};

constexpr size_t MB = (size_t)1 << 20;
constexpr size_t OFF_HH = 0, OFF_HL = 32 * MB, OFF_RTB = 32 * MB, OFF_QHI = 64 * MB, OFF_QLO = 96 * MB, OFF_YR = 96 * MB,
                 OFF_QR = 128 * MB, OFF_KR = 144 * MB, OFF_KRTD = 160 * MB, OFF_VRT = 176 * MB, OFF_KS = 208 * MB, OFF_KW = 212 * MB,
                 OFF_VST = 216 * MB, OFF_VWT = 220 * MB, OFF_PBUF = 208 * MB, OFF_GATES = 224 * MB, OFF_KCH = 227 * MB,
                 OFF_KCL = 227 * MB + 256 * 1024, OFF_VCT = 227 * MB + 512 * 1024, OFF_WBA = 228 * MB, OFF_WBB = 230 * MB,
                 OFF_WOUT = 232 * MB, OFF_WGU = 234 * MB, OFF_WD = 245 * MB, OFF_W1LO = 250 * MB + 512 * 1024,
                 OFF_SSQ1 = 253 * MB, OFF_SSQ2 = 253 * MB + 512 * 1024, OFF_CTR = 254 * MB, OFF_BAR = 254 * MB + 4096,
                 OFF_MERGEDF = 128 * MB, OFF_MERGED = 32 * MB, OFF_MIX = 128 * MB, OFF_H2 = 0, OFF_ACT = 32 * MB, OFF_F = 128 * MB;
constexpr size_t OO_W1T = 0, OO_CS64 = 14 * MB, OO_CS128 = 18 * MB, OO_UT = 14 * MB, OO_KC = 46 * MB, OO_VC = 54 * MB, OO_GB = 46 * MB;
constexpr size_t OFF_G = 32 * MB;
constexpr size_t OFF_GA = 160 * MB;

__device__ __forceinline__ int otid() { int t = threadIdx.x; asm volatile("" : "+v"(t)); return t; }
__device__ __forceinline__ int obid() { int b = blockIdx.x; asm volatile("" : "+s"(b)); return b; }
__device__ __forceinline__ u16 f2bf(float f) {
  unsigned u = __float_as_uint(f);
  u += 0x7fffu + ((u >> 16) & 1u);
  return (u16)(u >> 16);
}
__device__ __forceinline__ u16 f2h(float f) { union { _Float16 h; u16 u; } t; t.h = (_Float16)f; return t.u; }
__device__ __forceinline__ unsigned packh2(float a, float b) { return (unsigned)f2h(a) | ((unsigned)f2h(b) << 16); }
__device__ __forceinline__ f32x4 mfma16(bf16x8 a, bf16x8 b, f32x4 c) {
  union { bf16x8 s; f16x8 h; } ta, tb; ta.s = a; tb.s = b;
  return __builtin_amdgcn_mfma_f32_16x16x32_f16(ta.h, tb.h, c, 0, 0, 0);
}
__device__ __forceinline__ float bf2f(u16 h) { return __uint_as_float(((unsigned)h) << 16); }
__device__ __forceinline__ unsigned pack2(float a, float b) { return (unsigned)f2bf(a) | ((unsigned)f2bf(b) << 16); }
__device__ __forceinline__ float sigmoidf_(float x) { return 1.f / (1.f + __expf(-x)); }
__device__ __forceinline__ float siluf_(float x) { return x / (1.f + __expf(-x)); }

__device__ __forceinline__ float logg_of(int hd) {
  return hd == 0 ? -0.0317486972f : (hd == 1 ? -0.0157483574f : (hd == 2 ? -0.00784317777f : -0.00391389942f));
}

#define BK 64
#define LDT 72
#define SMEM_BYTES 73744

__device__ __forceinline__ void zero_acc(f32x4 (&acc)[2][8]) {
#pragma unroll
  for (int a = 0; a < 2; a++)
#pragma unroll
    for (int b = 0; b < 8; b++) acc[a][b] = f32x4{0.f, 0.f, 0.f, 0.f};
}

#define GBUF (2 * 128 * LDT)
__device__ __forceinline__ void gemm_store(const u32x4 (&ra)[4], const u32x4 (&rb)[4], u16* sA, int lrow, int lc) {
#pragma unroll
  for (int i = 0; i < 4; i++) {
    *(u32x4*)(sA + (lrow + i * 32) * LDT + lc) = ra[i];
    *(u32x4*)(sA + 128 * LDT + (lrow + i * 32) * LDT + lc) = rb[i];
  }
}
__device__ __forceinline__ void gemm_load(u32x4 (&ra)[4], u32x4 (&rb)[4], const u16* pa, const u16* pb, int lda, int ldb) {
#pragma unroll
  for (int i = 0; i < 4; i++) {
    ra[i] = *(const u32x4*)(pa + (size_t)(i * 32) * lda);
    rb[i] = *(const u32x4*)(pb + (size_t)(i * 32) * ldb);
  }
}
template <bool F16>
__device__ __forceinline__ void gemm_compute(f32x4 (&acc)[2][8], const u16* sA, int wave, int quad, int r16) {
  const u16* sB = sA + 128 * LDT;
  __builtin_amdgcn_s_setprio(2);
#pragma unroll
  for (int ks = 0; ks < 2; ks++) {
    bf16x8 af[2];
#pragma unroll
    for (int mt = 0; mt < 2; mt++) af[mt] = *(const bf16x8*)(sA + (wave * 32 + mt * 16 + r16) * LDT + ks * 32 + quad * 8);
#pragma unroll
    for (int nh = 0; nh < 2; nh++) {
      bf16x8 bfr[4];
#pragma unroll
      for (int nt = 0; nt < 4; nt++) bfr[nt] = *(const bf16x8*)(sB + ((nh * 4 + nt) * 16 + r16) * LDT + ks * 32 + quad * 8);
#pragma unroll
      for (int mt = 0; mt < 2; mt++)
#pragma unroll
        for (int nt = 0; nt < 4; nt++)
          acc[mt][nh * 4 + nt] = F16 ? mfma16(af[mt], bfr[nt], acc[mt][nh * 4 + nt])
                                     : __builtin_amdgcn_mfma_f32_16x16x32_bf16(af[mt], bfr[nt], acc[mt][nh * 4 + nt], 0, 0, 0);
    }
  }
  __builtin_amdgcn_s_setprio(0);
}

template <bool F16 = false>
__device__ __forceinline__ void gemm_acc(f32x4 (&acc)[2][8], const u16* A, int lda, const u16* B, int ldb, int K, u16* sA, u16*  ) {
  const int tid = otid(), lane = tid & 63, wave = tid >> 6, quad = lane >> 4, r16 = lane & 15;
  const int lrow = tid >> 3, lc = (tid & 7) * 8;
  const u16* pa = A + (size_t)lrow * lda + lc;
  const u16* pb = B + (size_t)lrow * ldb + lc;
  u16* s0 = sA;
  u16* s1 = sA + GBUF;
  u32x4 ra0[4], rb0[4], ra1[4], rb1[4];
  const int nk = K / BK;
  gemm_load(ra0, rb0, pa, pb, lda, ldb);
  gemm_load(ra1, rb1, pa + BK, pb + BK, lda, ldb);
  __syncthreads();
  gemm_store(ra0, rb0, s0, lrow, lc);
  if (nk > 2) gemm_load(ra0, rb0, pa + 2 * BK, pb + 2 * BK, lda, ldb);
  __syncthreads();
  for (int kt = 0; kt < nk; kt += 2) {
    gemm_compute<F16>(acc, s0, wave, quad, r16);
    __builtin_amdgcn_sched_barrier(0);
    gemm_store(ra1, rb1, s1, lrow, lc);
    if (kt + 3 < nk) gemm_load(ra1, rb1, pa + (kt + 3) * BK, pb + (kt + 3) * BK, lda, ldb);
    __syncthreads();
    gemm_compute<F16>(acc, s1, wave, quad, r16);
    __builtin_amdgcn_sched_barrier(0);
    if (kt + 2 < nk) {
      gemm_store(ra0, rb0, s0, lrow, lc);
      if (kt + 4 < nk) gemm_load(ra0, rb0, pa + (kt + 4) * BK, pb + (kt + 4) * BK, lda, ldb);
    }
    __syncthreads();
  }
}

__device__ __forceinline__ void gemm_acc_wide(f32x4 (&acc)[2][16], const u16* A, int lda, const u16* B, int ldb, int K, u16* sA) {
  const int tid = otid(), lane = tid & 63, wave = tid >> 6, quad = lane >> 4, r16 = lane & 15;
  const int lrow = tid >> 3, lc = (tid & 7) * 8;
  const u16* pa = A + (size_t)lrow * lda + lc;
  const u16* pb = B + (size_t)lrow * ldb + lc;
  u16* sB = sA + 128 * LDT;
  u32x4 ra[4], rb[8];
#pragma unroll
  for (int i = 0; i < 4; i++) ra[i] = *(const u32x4*)(pa + (size_t)(i * 32) * lda);
#pragma unroll
  for (int i = 0; i < 8; i++) rb[i] = *(const u32x4*)(pb + (size_t)(i * 32) * ldb);
  const int nk = K / BK;
  for (int kt = 0; kt < nk; kt++) {
    __syncthreads();
#pragma unroll
    for (int i = 0; i < 4; i++) *(u32x4*)(sA + (lrow + i * 32) * LDT + lc) = ra[i];
#pragma unroll
    for (int i = 0; i < 8; i++) *(u32x4*)(sB + (lrow + i * 32) * LDT + lc) = rb[i];
    __syncthreads();
    if (kt + 1 < nk) {
      pa += BK; pb += BK;
#pragma unroll
      for (int i = 0; i < 4; i++) ra[i] = *(const u32x4*)(pa + (size_t)(i * 32) * lda);
#pragma unroll
      for (int i = 0; i < 8; i++) rb[i] = *(const u32x4*)(pb + (size_t)(i * 32) * ldb);
    }
    __builtin_amdgcn_s_setprio(2);
#pragma unroll
    for (int ks = 0; ks < 2; ks++) {
      bf16x8 af[2];
#pragma unroll
      for (int mt = 0; mt < 2; mt++) af[mt] = *(const bf16x8*)(sA + (wave * 32 + mt * 16 + r16) * LDT + ks * 32 + quad * 8);
#pragma unroll
      for (int nq = 0; nq < 4; nq++) {
        bf16x8 bfr[4];
#pragma unroll
        for (int nt = 0; nt < 4; nt++) bfr[nt] = *(const bf16x8*)(sB + ((nq * 4 + nt) * 16 + r16) * LDT + ks * 32 + quad * 8);
#pragma unroll
        for (int mt = 0; mt < 2; mt++)
#pragma unroll
          for (int nt = 0; nt < 4; nt++)
            acc[mt][nq * 4 + nt] = __builtin_amdgcn_mfma_f32_16x16x32_bf16(af[mt], bfr[nt], acc[mt][nq * 4 + nt], 0, 0, 0);
      }
    }
    __builtin_amdgcn_s_setprio(0);
  }
  __syncthreads();
}

__device__ const float ROPE_INV[96] = {1.0f, 0.749894202f, 0.562341332f, 0.421696514f, 0.316227764f, 0.237137377f, 0.177827939f, 0.133352146f, 0.100000001f, 0.0749894232f, 0.0562341325f, 0.0421696492f, 0.0316227749f, 0.0237137377f, 0.0177827943f, 0.013335214f, 0.00999999978f, 0.00749894232f, 0.00562341325f, 0.00421696482f, 0.00316227763f, 0.00237137382f, 0.00177827943f, 0.00133352145f, 0.00100000005f, 0.000749894185f, 0.000562341302f, 0.000421696517f, 0.000316227757f, 0.00023713737f, 0.00017782794f, 0.00013335215f, 1.0f, 0.865964353f, 0.749894202f, 0.649381638f, 0.562341332f, 0.486967534f, 0.421696514f, 0.365174115f, 0.316227764f, 0.273841977f, 0.237137377f, 0.2053525f, 0.177827939f, 0.153992653f, 0.133352146f, 0.115478195f, 0.100000001f, 0.0865964293f, 0.0749894232f, 0.0649381652f, 0.0562341325f, 0.0486967526f, 0.0421696492f, 0.0365174115f, 0.0316227749f, 0.0273841955f, 0.0237137377f, 0.0205352511f, 0.0177827943f, 0.0153992651f, 0.013335214f, 0.0115478197f, 0.00999999978f, 0.00865964312f, 0.00749894232f, 0.00649381615f, 0.00562341325f, 0.00486967526f, 0.00421696482f, 0.00365174119f, 0.00316227763f, 0.00273841969f, 0.00237137382f, 0.00205352507f, 0.00177827943f, 0.00153992651f, 0.00133352145f, 0.00115478202f, 0.00100000005f, 0.000865964335f, 0.000749894185f, 0.000649381604f, 0.000562341302f, 0.000486967532f, 0.000421696517f, 0.000365174114f, 0.000316227757f, 0.000273841957f, 0.00023713737f, 0.00020535251f, 0.00017782794f, 0.00015399266f, 0.00013335215f, 0.0001154782f};

__device__ __forceinline__ bool next_tile(int it, int Mt, int Nt, int SM, int SN, int& mt, int& nt, bool& valid) {
  const int G = gridDim.x, bid = obid();
  if (G == 512) {
    const int xcd = bid & 7, l = bid >> 3;
    const int nsm = (Mt + SM - 1) / SM, nsn = (Nt + SN - 1) / SN;
    const int sb = it * 8 + xcd;
    if (sb >= nsm * nsn) return false;
    const int sm = sb % nsm, sn = sb / nsm;
    mt = sm * SM + l / SN; nt = sn * SN + l % SN;
    valid = (mt < Mt) && (nt < Nt);
    return true;
  } else {
    const int task = bid + it * G;
    if (task >= Mt * Nt) return false;
    mt = task / Nt; nt = task % Nt; valid = true;
    return true;
  }
}

__device__ __forceinline__ void tconv_tile(const float* src, int ld_src, int k0, int n_src0, int nvalid, u16* dst_hi, u16* dst_lo, int ld_dst,
                                           int n_dst0, float* tile) {
  const int tid = otid();
  __syncthreads();
#pragma unroll
  for (int i = 0; i < 4; i++) {
    const int r = i * 16 + (tid >> 4), c = (tid & 15) * 4;
    float4 v = float4{0.f, 0.f, 0.f, 0.f};
    if (c < nvalid) v = *(const float4*)(src + (size_t)(k0 + r) * ld_src + n_src0 + c);
    tile[r * 65 + c] = v.x; tile[r * 65 + c + 1] = v.y; tile[r * 65 + c + 2] = v.z; tile[r * 65 + c + 3] = v.w;
  }
  __syncthreads();
  const int n = tid >> 2, kc = (tid & 3) * 16;
  unsigned hi[8], lo[8];
#pragma unroll
  for (int e = 0; e < 8; e++) {
    float a = tile[(kc + 2 * e) * 65 + n], b = tile[(kc + 2 * e + 1) * 65 + n];
    u16 ah = f2bf(a), bh = f2bf(b);
    hi[e] = (unsigned)ah | ((unsigned)bh << 16);
    lo[e] = packh2(a, b);
  }
  u16* d = dst_hi + (size_t)(n_dst0 + n) * ld_dst + k0 + kc;
  *(uint4*)d = uint4{hi[0], hi[1], hi[2], hi[3]};
  *(uint4*)(d + 8) = uint4{hi[4], hi[5], hi[6], hi[7]};
  if (dst_lo) {
    u16* dl = dst_lo + (size_t)(n_dst0 + n) * ld_dst + k0 + kc;
    *(uint4*)dl = uint4{lo[0], lo[1], lo[2], lo[3]};
    *(uint4*)(dl + 8) = uint4{lo[4], lo[5], lo[6], lo[7]};
  }
}

__device__ __forceinline__ void wdecode(const Params& p, int task, const float*& src, int& ld_src, int& k0, int& ns, int& nv, u16*& dhi, u16*& dlo,
                                        int& ld_dst, int& nd) {
  char* ws = p.ws;
  char* oo = (char*)p.out;
  nv = 64; dlo = nullptr;
  if (task < 1760) {
    const int a = task >> 4, kt = task & 15;
    nd = a * 64;
    if (nd < 1792) ns = nd;
    else if (nd == 1792) { ns = 1792; nv = 48; }
    else if (nd == 1856) { ns = 0; nv = 0; }
    else ns = nd - 80;
    src = p.w_in; ld_src = 6960; k0 = kt * 64; dhi = (u16*)(oo + OO_W1T); dlo = (nd < 1152) ? (u16*)(ws + OFF_W1LO) : nullptr; ld_dst = 1024;
  } else if (task < 2528) {
    const int t = task - 1760, wsel = t >> 8, r = t & 255, a = r >> 4, kt = r & 15;
    src = wsel == 0 ? p.wba : (wsel == 1 ? p.wbb : p.wout);
    dhi = (u16*)(ws + (wsel == 0 ? OFF_WBA : (wsel == 1 ? OFF_WBB : OFF_WOUT)));
    ld_src = 1024; k0 = kt * 64; ns = a * 64; ld_dst = 1024; nd = a * 64;
  } else if (task < 3936) {
    const int t = task - 2528, a = t >> 4, kt = t & 15;
    src = (a & 1) ? p.wu : p.wg;
    ld_src = 2816; k0 = kt * 64; ns = (a >> 1) * 64; dhi = (u16*)(ws + OFF_WGU); ld_dst = 1024; nd = a * 64;
  } else {
    const int t = task - 3936, a = t / 44, kt = t % 44;
    src = p.wd; ld_src = 1024; k0 = kt * 64; ns = a * 64; dhi = (u16*)(ws + OFF_WD); ld_dst = 2816; nd = a * 64;
  }
}
__device__ __forceinline__ void tconv_load(f32x4 (&v)[4], const float* src, int ld_src, int k0, int ns, int nv, int tid) {
#pragma unroll
  for (int i = 0; i < 4; i++) {
    const int r = i * 16 + (tid >> 4), c = (tid & 15) * 4;
    v[i] = f32x4{0.f, 0.f, 0.f, 0.f};
    if (c < nv) v[i] = *(const f32x4*)(src + (size_t)(k0 + r) * ld_src + ns + c);
  }
}
__device__ __forceinline__ void tconv_finish(const f32x4 (&v)[4], int k0, u16* dst_hi, u16* dst_lo, int ld_dst, int n_dst0, float* tile, int tid) {
  __syncthreads();
#pragma unroll
  for (int i = 0; i < 4; i++) {
    const int r = i * 16 + (tid >> 4), c = (tid & 15) * 4;
    tile[r * 65 + c] = v[i][0]; tile[r * 65 + c + 1] = v[i][1]; tile[r * 65 + c + 2] = v[i][2]; tile[r * 65 + c + 3] = v[i][3];
  }
  __syncthreads();
  const int n = tid >> 2, kc = (tid & 3) * 16;
  unsigned hi[8], lo[8];
#pragma unroll
  for (int e = 0; e < 8; e++) {
    float a = tile[(kc + 2 * e) * 65 + n], b = tile[(kc + 2 * e + 1) * 65 + n];
    u16 ah = f2bf(a), bh = f2bf(b);
    hi[e] = (unsigned)ah | ((unsigned)bh << 16);
    lo[e] = packh2(a, b);
  }
  u16* d = dst_hi + (size_t)(n_dst0 + n) * ld_dst + k0 + kc;
  *(u32x4*)d = u32x4{hi[0], hi[1], hi[2], hi[3]};
  *(u32x4*)(d + 8) = u32x4{hi[4], hi[5], hi[6], hi[7]};
  if (dst_lo) {
    u16* dl = dst_lo + (size_t)(n_dst0 + n) * ld_dst + k0 + kc;
    *(u32x4*)dl = u32x4{lo[0], lo[1], lo[2], lo[3]};
    *(u32x4*)(dl + 8) = u32x4{lo[4], lo[5], lo[6], lo[7]};
  }
}

__device__ __forceinline__ void phase0(const Params& p, char* smem) {
  char* ws = p.ws;
  char* oo = (char*)p.out;
  float* tile = (float*)smem;
  const int tid = otid(), lane = tid & 63, wave = tid >> 6;
  if (obid() == 0 && tid < 4) ((unsigned*)(ws + OFF_CTR))[tid] = 0u;
  {
    const int G = gridDim.x;
    int task = obid();
    const float* srcA; int ldsA, k0A, nsA, nvA, lddA, ndA; u16 *dhiA, *dloA;
    f32x4 vA[4], vB[4];
    if (task < 4640) { wdecode(p, task, srcA, ldsA, k0A, nsA, nvA, dhiA, dloA, lddA, ndA); tconv_load(vA, srcA, ldsA, k0A, nsA, nvA, tid); }
    while (task < 4640) {
      const int nt = task + G;
      const float* srcB = srcA; int ldsB = ldsA, k0B = k0A, nsB = nsA, nvB = nvA, lddB = lddA, ndB = ndA; u16 *dhiB = dhiA, *dloB = dloA;
      if (nt < 4640) { wdecode(p, nt, srcB, ldsB, k0B, nsB, nvB, dhiB, dloB, lddB, ndB); tconv_load(vB, srcB, ldsB, k0B, nsB, nvB, tid); }
      tconv_finish(vA, k0A, dhiA, dloA, lddA, ndA, tile, tid);
#pragma unroll
      for (int i = 0; i < 4; i++) vA[i] = vB[i];
      srcA = srcB; ldsA = ldsB; k0A = k0B; nsA = nsB; nvA = nvB; lddA = lddB; ndA = ndB; dhiA = dhiB; dloA = dloB;
      task = nt;
    }
  }
  const int gw = obid() * 4 + wave, nw = gridDim.x * 4;
  u16* hh = (u16*)(ws + OFF_HH);
  u16* hl = (u16*)(ws + OFF_HL);
  for (int row0 = gw * 4; row0 < S_; row0 += nw * 4) {
    f32x4 v[4][4], g[4];
    float ss[4];
#pragma unroll
    for (int r = 0; r < 4; r++)
#pragma unroll
      for (int i = 0; i < 4; i++) v[r][i] = ((const f32x4*)(p.x + (size_t)(row0 + r) * 1024))[lane + 64 * i];
#pragma unroll
    for (int i = 0; i < 4; i++) g[i] = ((const f32x4*)p.g_pre_mix)[lane + 64 * i];
#pragma unroll
    for (int r = 0; r < 4; r++) {
      ss[r] = 0.f;
#pragma unroll
      for (int i = 0; i < 4; i++) ss[r] += v[r][i][0] * v[r][i][0] + v[r][i][1] * v[r][i][1] + v[r][i][2] * v[r][i][2] + v[r][i][3] * v[r][i][3];
    }
#pragma unroll
    for (int o = 32; o >= 1; o >>= 1)
#pragma unroll
      for (int r = 0; r < 4; r++) ss[r] += __shfl_xor(ss[r], o);
#pragma unroll
    for (int r = 0; r < 4; r++) {
      const float rs = rsqrtf(ss[r] * (1.f / 1024.f) + 1e-6f);
#pragma unroll
      for (int i = 0; i < 4; i++) {
        const f32x4 y = v[r][i] * rs * g[i];
        u32x2 H, L;
        H.x = pack2(y[0], y[1]); H.y = pack2(y[2], y[3]);
        L.x = packh2(y[0], y[1]); L.y = packh2(y[2], y[3]);
        *(u32x2*)(hh + (size_t)(row0 + r) * 1024 + (lane + 64 * i) * 4) = H;
        *(u32x2*)(hl + (size_t)(row0 + r) * 1024 + (lane + 64 * i) * 4) = L;
      }
    }
  }
  float2* cs64 = (float2*)(oo + OO_CS64);
  float2* cs128 = (float2*)(oo + OO_CS128);
  const int gt = obid() * 256 + tid, nt = gridDim.x * 256;
  for (int e = gt; e < S_ * 64; e += nt) {
    const int t = e >> 6, i = e & 63;
    const float ang = (float)t * ROPE_INV[32 + i];
    float sn, cn;
    sincosf(ang, &sn, &cn);
    cs128[t * 64 + i] = float2{cn, sn};
    if (!(i & 1)) cs64[t * 32 + (i >> 1)] = float2{cn, sn};
  }
}

__device__ __forceinline__ void p1_epilogue(const Params& p, int nti, int m0, f32x4 (&acc)[2][8]) {
  char* ws = p.ws;
  char* oo = (char*)p.out;
  const int tid = otid(), lane = tid & 63, wave = tid >> 6, quad = lane >> 4, r16 = lane & 15;
  const int rbase = m0 + wave * 32 + quad * 4;
  const bool rope64 = (nti <= 8) || nti == 10 || nti == 12;
  const bool rope128 = (nti >= 15 && nti <= 22);
  if (rope64) {
    const float2* cs64 = (const float2*)(oo + OO_CS64);
#pragma unroll
    for (int mt = 0; mt < 2; mt++)
#pragma unroll
      for (int i = 0; i < 4; i++) {
        int tok = rbase + mt * 16 + i;
#pragma unroll
        for (int j = 0; j < 2; j++) {
          float2 cs = cs64[tok * 32 + j * 16 + r16];
#pragma unroll
          for (int hh = 0; hh < 2; hh++) {
            float x1 = acc[mt][hh * 4 + j][i], x2 = acc[mt][hh * 4 + j + 2][i];
            acc[mt][hh * 4 + j][i] = x1 * cs.x - x2 * cs.y;
            acc[mt][hh * 4 + j + 2][i] = x2 * cs.x + x1 * cs.y;
          }
        }
      }
  } else if (rope128) {
    const float2* cs128 = (const float2*)(oo + OO_CS128);
    const float sc = (nti <= 18) ? 0.08838834764831845f : 1.f;
#pragma unroll
    for (int mt = 0; mt < 2; mt++)
#pragma unroll
      for (int i = 0; i < 4; i++) {
        int tok = rbase + mt * 16 + i;
#pragma unroll
        for (int j = 0; j < 4; j++) {
          float2 cs = cs128[tok * 64 + j * 16 + r16];
          float x1 = acc[mt][j][i], x2 = acc[mt][j + 4][i];
          acc[mt][j][i] = (x1 * cs.x - x2 * cs.y) * sc;
          acc[mt][j + 4][i] = (x2 * cs.x + x1 * cs.y) * sc;
        }
      }
  }
  if (nti < 8) {
    u16* qh = (u16*)(ws + OFF_QHI);
    u16* ql = (u16*)(ws + OFF_QLO);
#pragma unroll
    for (int mt = 0; mt < 2; mt++)
#pragma unroll
      for (int nt = 0; nt < 8; nt++)
#pragma unroll
        for (int i = 0; i < 4; i++) {
          int tok = rbase + mt * 16 + i, col = nti * 128 + nt * 16 + r16;
          float v = acc[mt][nt][i];
          qh[(size_t)tok * 1024 + col] = f2bf(v);
          ql[(size_t)tok * 1024 + col] = f2h(v);
        }
  } else if (nti == 8 || nti == 9) {
    float* dst = (float*)(oo + (nti == 8 ? OO_KC : OO_VC));
#pragma unroll
    for (int mt = 0; mt < 2; mt++)
#pragma unroll
      for (int nt = 0; nt < 8; nt++)
#pragma unroll
        for (int i = 0; i < 4; i++) dst[(size_t)(rbase + mt * 16 + i) * 128 + nt * 16 + r16] = acc[mt][nt][i];
  } else if (nti == 10) {
    u16* dst = (u16*)(ws + OFF_KS);
#pragma unroll
    for (int mt = 0; mt < 2; mt++)
#pragma unroll
      for (int nt = 0; nt < 8; nt++)
#pragma unroll
        for (int i = 0; i < 4; i++) {
          const int tok = rbase + mt * 16 + i, col = nt * 16 + r16;
          const int kvh = col >> 6, d = col & 63;
          const size_t idx = (((((size_t)kvh * 256 + (tok >> 6)) * 4 + ((tok >> 4) & 3)) * 2 + (d >> 5)) * 64 + ((d >> 3) & 3) * 16 + (tok & 15)) * 8 + (d & 7);
          dst[idx] = f2bf(acc[mt][nt][i]);
        }
  } else if (nti == 12) {
    u16* dst = (u16*)(ws + OFF_KW);
#pragma unroll
    for (int mt = 0; mt < 2; mt++)
#pragma unroll
      for (int nt = 0; nt < 8; nt++)
#pragma unroll
        for (int i = 0; i < 4; i++) dst[(size_t)(rbase + mt * 16 + i) * 128 + nt * 16 + r16] = f2bf(acc[mt][nt][i]);
  } else if (nti == 11) {
    u16* dst = (u16*)(ws + OFF_VST);
#pragma unroll
    for (int mt = 0; mt < 2; mt++)
#pragma unroll
      for (int nt = 0; nt < 8; nt++) {
        const int tok = rbase + mt * 16, col = nt * 16 + r16;
        const int kvh = col >> 6, d = col & 63, kap = tok & 63;
        const int kk = kap >> 5, half = (kap >> 4) & 1, q = (kap >> 2) & 3;
        const size_t idx = (((((size_t)kvh * 256 + (tok >> 6)) * 2 + kk) * 4 + (d >> 4)) * 64 + q * 16 + (d & 15)) * 8 + 4 * half;
        uint2 v;
        v.x = pack2(acc[mt][nt][0], acc[mt][nt][1]);
        v.y = pack2(acc[mt][nt][2], acc[mt][nt][3]);
        *(uint2*)(dst + idx) = v;
      }
  } else if (nti == 13) {
    u16* dst = (u16*)(ws + OFF_VWT);
#pragma unroll
    for (int mt = 0; mt < 2; mt++)
#pragma unroll
      for (int nt = 0; nt < 8; nt++) {
        uint2 v;
        v.x = pack2(acc[mt][nt][0], acc[mt][nt][1]);
        v.y = pack2(acc[mt][nt][2], acc[mt][nt][3]);
        *(uint2*)(dst + (size_t)(nt * 16 + r16) * S_ + rbase + mt * 16) = v;
      }
  } else if (nti == 14) {
    float* dst = (float*)(ws + OFF_GATES);
#pragma unroll
    for (int mt = 0; mt < 2; mt++)
#pragma unroll
      for (int nt = 0; nt < 3; nt++)
#pragma unroll
        for (int i = 0; i < 4; i++) dst[(size_t)(rbase + mt * 16 + i) * 48 + nt * 16 + r16] = sigmoidf_(acc[mt][nt][i]);
  } else if (nti <= 18) {
    u16* dst = (u16*)(ws + OFF_QR);
    const int hd = nti - 15;
#pragma unroll
    for (int mt = 0; mt < 2; mt++)
#pragma unroll
      for (int nt = 0; nt < 8; nt++)
#pragma unroll
        for (int i = 0; i < 4; i++) dst[(size_t)(rbase + mt * 16 + i) * 512 + hd * 128 + nt * 16 + r16] = f2bf(acc[mt][nt][i]);
  } else if (nti <= 22) {
    u16* dst = (u16*)(ws + OFF_KR);
    u16* dstT = (u16*)(ws + OFF_KRTD);
    const int hd = nti - 19;
    const float logg = logg_of(hd);
#pragma unroll
    for (int mt = 0; mt < 2; mt++) {
      float dk[4];
#pragma unroll
      for (int i = 0; i < 4; i++) dk[i] = __expf(logg * (float)(127 - ((rbase + mt * 16 + i) & 127)));
#pragma unroll
      for (int nt = 0; nt < 8; nt++) {
#pragma unroll
        for (int i = 0; i < 4; i++) dst[(size_t)(rbase + mt * 16 + i) * 512 + hd * 128 + nt * 16 + r16] = f2bf(acc[mt][nt][i]);
        uint2 v;
        v.x = pack2(acc[mt][nt][0] * dk[0], acc[mt][nt][1] * dk[1]);
        v.y = pack2(acc[mt][nt][2] * dk[2], acc[mt][nt][3] * dk[3]);
        *(uint2*)(dstT + (size_t)(hd * 128 + nt * 16 + r16) * S_ + rbase + mt * 16) = v;
      }
    }
  } else {
    u16* dstT = (u16*)(ws + OFF_VRT);
    const int cb = (nti - 23) * 128;
#pragma unroll
    for (int mt = 0; mt < 2; mt++)
#pragma unroll
      for (int nt = 0; nt < 8; nt++) {
        uint2 v;
        v.x = pack2(acc[mt][nt][0], acc[mt][nt][1]);
        v.y = pack2(acc[mt][nt][2], acc[mt][nt][3]);
        *(uint2*)(dstT + (size_t)(cb + nt * 16 + r16) * S_ + rbase + mt * 16) = v;
      }
  }
}

__device__ __forceinline__ void phase1(const Params& p, char* smem) {
  u16* sA = (u16*)smem;
  u16* sB = sA + 128 * LDT;
  const u16* hh = (const u16*)(p.ws + OFF_HH);
  const u16* hl = (const u16*)(p.ws + OFF_HL);
  const u16* w1 = (const u16*)((char*)p.out + OO_W1T);
  const u16* w1lo = (const u16*)(p.ws + OFF_W1LO);
  for (int it = 0;; it++) {
    int mtile, nti; bool valid;
    if (!next_tile(it, 128, 31, 8, 8, mtile, nti, valid)) break;
    if (!valid) continue;
    const int m0 = mtile * 128, n0 = nti * 128;
    f32x4 acc[2][8];
    zero_acc(acc);
    if (nti < 9) gemm_acc<true>(acc, hl + (size_t)m0 * 1024, 1024, w1lo + (size_t)n0 * 1024, 1024, 1024, sA, sB);
    else gemm_acc(acc, hh + (size_t)m0 * 1024, 1024, w1 + (size_t)n0 * 1024, 1024, 1024, sA, sB);
    p1_epilogue(p, nti, m0, acc);
  }
}

__device__ __forceinline__ void phase2(const Params& p, char* smem) {
  float* tile = (float*)smem;
  float* posl = tile + 144 * 64;
  float* red = tile;
  float* hid = posl + 32 * 64;
  const int tid = otid();
  char* oo = (char*)p.out;
  for (int task = obid(); task < 512; task += gridDim.x) {
    const int which = task >> 8, head = (task >> 7) & 1, g = task & 127;
    const float* src = (const float*)(oo + (which ? OO_VC : OO_KC));
    const float* pos = which ? p.cpv : p.cpk;
    const float* w1 = which ? p.cw1v : p.cw1k;
    const float* w2 = which ? p.cw2v : p.cw2k;
    __syncthreads();
#pragma unroll
    for (int i = 0; i < 9; i++) {
      int id = tid + 256 * i, tk = id >> 4, c4 = id & 15, tok = 128 * g + tk;
      float4 v = float4{0.f, 0.f, 0.f, 0.f};
      if (tok < S_) v = *(const float4*)(src + (size_t)tok * 128 + head * 64 + c4 * 4);
      ((float4*)tile)[tk * 16 + c4] = v;
    }
#pragma unroll
    for (int i = 0; i < 2; i++) ((float4*)posl)[tid + 256 * i] = ((const float4*)pos)[tid + 256 * i];
    __syncthreads();
    const int j4 = tid & 31, kp = tid >> 5;
    float acc[9][4];
#pragma unroll
    for (int r = 0; r < 9; r++)
#pragma unroll
      for (int cc = 0; cc < 4; cc++) acc[r][cc] = 0.f;
    for (int l = kp * 4; l < kp * 4 + 4; l++) {
#pragma unroll 2
      for (int d4 = 0; d4 < 16; d4++) {
        const int kk = l * 64 + d4 * 4;
        float4 wv[4];
#pragma unroll
        for (int q = 0; q < 4; q++) wv[q] = *(const float4*)(w1 + (size_t)(kk + q) * 128 + j4 * 4);
#pragma unroll
        for (int r = 0; r < 9; r++) {
          const float4 xv = (r < 8) ? ((const float4*)tile)[(16 * r + l) * 16 + d4] : ((const float4*)posl)[l * 16 + d4];
          acc[r][0] += xv.x * wv[0].x + xv.y * wv[1].x + xv.z * wv[2].x + xv.w * wv[3].x;
          acc[r][1] += xv.x * wv[0].y + xv.y * wv[1].y + xv.z * wv[2].y + xv.w * wv[3].y;
          acc[r][2] += xv.x * wv[0].z + xv.y * wv[1].z + xv.z * wv[2].z + xv.w * wv[3].z;
          acc[r][3] += xv.x * wv[0].w + xv.y * wv[1].w + xv.z * wv[2].w + xv.w * wv[3].w;
        }
      }
    }
    __syncthreads();
#pragma unroll
    for (int r = 0; r < 9; r++) *(float4*)(red + (kp * 9 + r) * 128 + j4 * 4) = float4{acc[r][0], acc[r][1], acc[r][2], acc[r][3]};
    __syncthreads();
#pragma unroll
    for (int i = 0; i < 4; i++) {
      int id = tid + 256 * i, r = id >> 7, jj = id & 127;
      float xh = 0.f;
#pragma unroll
      for (int k = 0; k < 8; k++) xh += red[(k * 9 + r) * 128 + jj] + red[(k * 9 + 8) * 128 + jj];
      float u = 0.7978845608028654f * (xh + 0.044715f * xh * xh * xh);
      hid[r * 128 + jj] = 0.5f * xh * (2.f - 2.f / (1.f + __expf(2.f * u)));
    }
    __syncthreads();
    {
      const int r = tid >> 5, d = (tid & 31) * 2;
      float o0 = 0.f, o1 = 0.f;
      for (int jj = 0; jj < 128; jj++) {
        float hv = hid[r * 128 + jj];
        float2 wv = *(const float2*)(w2 + jj * 64 + d);
        o0 += hv * wv.x; o1 += hv * wv.y;
      }
      const int n = g * 8 + r;
      if (n == 1023) { o0 = 0.f; o1 = 0.f; }
      if (which == 0) {
        u16* kh_ = (u16*)(p.ws + OFF_KCH);
        u16* kl_ = (u16*)(p.ws + OFF_KCL);
        *(unsigned*)(kh_ + n * 128 + head * 64 + d) = packh2(o0, o1);
        (void)kl_;
      } else {
        u16* vt = (u16*)(p.ws + OFF_VCT);
        vt[(head * 64 + d) * 1024 + n] = f2bf(o0);
        vt[(head * 64 + d + 1) * 1024 + n] = f2bf(o1);
      }
    }
  }
}

__device__ __forceinline__ void phase2_ut(const Params& p, char* smem) {
  char* ws = p.ws;
  u16* sA = (u16*)smem;
  u16* sB = sA + 128 * LDT;
  const int tid = otid(), lane = tid & 63, wave = tid >> 6, quad = lane >> 4, r16 = lane & 15;
  u16* ut = (u16*)((char*)p.out + OO_UT);
  for (int task = obid(); task < 1024; task += gridDim.x) {
    const int cch = task >> 3, hd = (task >> 1) & 3, dvt = task & 1;
    const u16* vrt = (const u16*)(ws + OFF_VRT) + (size_t)(hd * 256 + dvt * 128) * S_ + cch * 128;
    const u16* krt = (const u16*)(ws + OFF_KRTD) + (size_t)(hd * 128) * S_ + cch * 128;
    f32x4 acc[2][8];
    zero_acc(acc);
    gemm_acc(acc, vrt, S_, krt, S_, 128, sA, sB);
    u16* dst = ut + ((size_t)(cch * 4 + hd) * 256 + dvt * 128) * 128;
#pragma unroll
    for (int mt = 0; mt < 2; mt++)
#pragma unroll
      for (int nt = 0; nt < 8; nt++)
#pragma unroll
        for (int i = 0; i < 4; i++) dst[(wave * 32 + mt * 16 + quad * 4 + i) * 128 + nt * 16 + r16] = f2bf(acc[mt][nt][i]);
  }
}

#define P3_KH 0
#define P3_KL 9216
#define P3_V 18432
#define P3_IMP 27648
#define P3_SEL (27648 + 4 * NG * 2 * 1040)
#define P3_SELN (P3_SEL + 4 * NG * 2 * 64)
#define P3_TASK (P3_SELN + 128)
#define P3T 72
#define NG 2

template <int CTRL>
__device__ __forceinline__ float dpp_f(float a) { return __int_as_float(__builtin_amdgcn_mov_dpp(__float_as_int(a), CTRL, 0xf, 0xf, true)); }
__device__ __forceinline__ float hsum8(float a) {
  a += dpp_f<0xB1>(a);
  a += dpp_f<0x4E>(a);
  a += dpp_f<0x141>(a);
  return a;
}

__device__ __forceinline__ void softmax_pv(f32x4 (&s)[4], int kbase, bool colactive, int tq, int W, const bf16x8 (&vf)[2][4], f32x4 (&o)[4],
                                           float& m_run, float& l_run, int quad) {
  float mx = NEGF;
  bool ok[4][4];
#pragma unroll
  for (int a = 0; a < 4; a++)
#pragma unroll
    for (int i = 0; i < 4; i++) {
      int kpos = kbase + 16 * a + 4 * quad + i;
      ok[a][i] = colactive && (kpos <= tq) && (kpos > tq - W);
      s[a][i] *= 0.125f;
      if (ok[a][i]) mx = fmaxf(mx, s[a][i]);
    }
  mx = fmaxf(mx, __shfl_xor(mx, 16));
  mx = fmaxf(mx, __shfl_xor(mx, 32));
  const float m_new = fmaxf(m_run, mx);
  const float alpha = __expf(m_run - m_new);
  m_run = m_new;
  float ps = 0.f;
#pragma unroll
  for (int a = 0; a < 4; a++)
#pragma unroll
    for (int i = 0; i < 4; i++) {
      float pv = ok[a][i] ? __expf(s[a][i] - m_new) : 0.f;
      s[a][i] = pv;
      ps += pv;
    }
  l_run = l_run * alpha + ps;
#pragma unroll
  for (int dt = 0; dt < 4; dt++)
#pragma unroll
    for (int i = 0; i < 4; i++) o[dt][i] *= alpha;
#pragma unroll
  for (int kk = 0; kk < 2; kk++) {
    union { bf16x8 v; unsigned u[4]; } pf;
    pf.u[0] = pack2(s[2 * kk][0], s[2 * kk][1]);
    pf.u[1] = pack2(s[2 * kk][2], s[2 * kk][3]);
    pf.u[2] = pack2(s[2 * kk + 1][0], s[2 * kk + 1][1]);
    pf.u[3] = pack2(s[2 * kk + 1][2], s[2 * kk + 1][3]);
#pragma unroll
    for (int dt = 0; dt < 4; dt++) o[dt] = __builtin_amdgcn_mfma_f32_16x16x32_bf16(vf[kk][dt], pf.v, o[dt], 0, 0, 0);
  }
}

__device__ __forceinline__ void attn_tile_task(const Params& p, int qt, int kvh, char* smem) {
  char* ws = p.ws;
  const int tid = otid(), lane = tid & 63, wave = tid >> 6, quad = lane >> 4, c = lane & 15, qsel = c >> 3, h = c & 7;
  const int t0 = qt * (8 * NG), tw = t0 + wave * (2 * NG), H = kvh * 8 + h;
  u16* sKh = (u16*)(smem + P3_KH);
  u16* sKl = (u16*)(smem + P3_KL);
  u16* sV = (u16*)(smem + P3_V);
  volatile float* imp = (volatile float*)(smem + P3_IMP + wave * (NG * 2 * 1040));
  volatile int* sel = (volatile int*)(smem + P3_SEL + wave * (NG * 2 * 64));
  volatile int* seln = (volatile int*)(smem + P3_SELN + wave * 32);
  const u16* q_hi = (const u16*)(ws + OFF_QHI);
  const u16* q_lo = (const u16*)(ws + OFF_QLO);
  u16* part = (u16*)(ws + OFF_QLO);
  const float* gates = (const float*)(ws + OFF_GATES);
  const int lr = tid >> 3, lcc = (tid & 7) * 8;

#ifndef CMPREP
#define CMPREP 1
#endif
#pragma unroll 1
  for (int rep = 0; rep < CMPREP; rep++) {
    bf16x8 ql[NG][2];
    int nmaxq[NG];
#pragma unroll
    for (int g = 0; g < NG; g++) {
      const int tq = tw + 2 * g + qsel;
      nmaxq[g] = (tq - 31) >> 4;
#pragma unroll
      for (int ks = 0; ks < 2; ks++) {
        ql[g][ks] = *(const bf16x8*)(q_lo + (size_t)tq * 1024 + H * 64 + ks * 32 + quad * 8);
      }
    }
    const int nmaxt = (t0 + 8 * NG - 32) >> 4;
    const int NCH = nmaxt >= 0 ? (nmaxt >> 6) + 1 : 0;
    const u16* kch = (const u16*)(ws + OFF_KCH) + kvh * 64;
    const u16* kcl = (const u16*)(ws + OFF_KCL) + kvh * 64;
    const u16* vct = (const u16*)(ws + OFF_VCT) + (size_t)(kvh * 64) * 1024;
    float m_l[NG], l_l[NG];
#pragma unroll
    for (int g = 0; g < NG; g++) { m_l[g] = NEGF; l_l[g] = 0.f; }
    u32x4 pk[4], pv[2];
#pragma unroll
    for (int i = 0; i < 2; i++) {
      pk[i] = *(const u32x4*)(kch + (size_t)(lr + 32 * i) * 128 + lcc);
    }
    for (int ch = 0; ch < NCH; ch++) {
      __syncthreads();
#pragma unroll
      for (int i = 0; i < 2; i++) {
        *(u32x4*)(sKh + (lr + 32 * i) * P3T + lcc) = pk[i];
      }
      __syncthreads();
      if (ch + 1 < NCH) {
#pragma unroll
        for (int i = 0; i < 2; i++) {
          pk[i] = *(const u32x4*)(kch + (size_t)(64 * (ch + 1) + lr + 32 * i) * 128 + lcc);
        }
      }
#pragma unroll
      for (int a = 0; a < 4; a++) {
        bf16x8 kh_[2];
#pragma unroll
        for (int ks = 0; ks < 2; ks++) {
          kh_[ks] = *(const bf16x8*)(sKh + (16 * a + c) * P3T + ks * 32 + quad * 8);
        }
        const int nb = 64 * ch + 16 * a + 4 * quad;
#pragma unroll
        for (int g = 0; g < NG; g++) {
          f32x4 s = f32x4{0.f, 0.f, 0.f, 0.f};
#pragma unroll
          for (int ks = 0; ks < 2; ks++) {
            s = mfma16(kh_[ks], ql[g][ks], s);
          }
          float mx = NEGF;
#pragma unroll
          for (int i = 0; i < 4; i++) {
            s[i] *= 0.125f;
            if (nb + i <= nmaxq[g]) mx = fmaxf(mx, s[i]);
          }
          const float m_new = fmaxf(m_l[g], mx);
          float ll = l_l[g] * __expf(m_l[g] - m_new);
#pragma unroll
          for (int i = 0; i < 4; i++)
            if (nb + i <= nmaxq[g]) ll += __expf(s[i] - m_new);
          l_l[g] = ll;
          m_l[g] = m_new;
        }
      }
    }
    float Mx[NG], invL[NG];
#pragma unroll
    for (int g = 0; g < NG; g++) {
      float M = fmaxf(m_l[g], __shfl_xor(m_l[g], 16));
      M = fmaxf(M, __shfl_xor(M, 32));
      float ll = l_l[g] * __expf(m_l[g] - M);
      ll += __shfl_xor(ll, 16);
      ll += __shfl_xor(ll, 32);
      Mx[g] = M;
      invL[g] = (ll > 0.f) ? 1.f / ll : 0.f;
    }
    f32x4 ocmp[NG][4];
    float carry[NG];
#pragma unroll
    for (int g = 0; g < NG; g++) {
      carry[g] = 0.f;
#pragma unroll
      for (int dt = 0; dt < 4; dt++) ocmp[g][dt] = f32x4{0.f, 0.f, 0.f, 0.f};
    }
#pragma unroll
    for (int i = 0; i < 2; i++) {
      pk[i] = *(const u32x4*)(kch + (size_t)(lr + 32 * i) * 128 + lcc);
      pv[i] = *(const u32x4*)(vct + (size_t)(lr + 32 * i) * 1024 + lcc);
    }
    for (int ch = 0; ch < NCH; ch++) {
      __syncthreads();
#pragma unroll
      for (int i = 0; i < 2; i++) {
        *(u32x4*)(sKh + (lr + 32 * i) * P3T + lcc) = pk[i];
        *(u32x4*)(sV + (lr + 32 * i) * P3T + lcc) = pv[i];
      }
      __syncthreads();
      if (ch + 1 < NCH) {
#pragma unroll
        for (int i = 0; i < 2; i++) {
          pk[i] = *(const u32x4*)(kch + (size_t)(64 * (ch + 1) + lr + 32 * i) * 128 + lcc);
          pv[i] = *(const u32x4*)(vct + (size_t)(lr + 32 * i) * 1024 + 64 * (ch + 1) + lcc);
        }
      }
#pragma unroll
      for (int kk = 0; kk < 2; kk++) {
        float pr[NG][2][4];
#pragma unroll
        for (int e = 0; e < 2; e++) {
          const int a = 2 * kk + e;
          bf16x8 kh_[2];
#pragma unroll
          for (int ks = 0; ks < 2; ks++) {
            kh_[ks] = *(const bf16x8*)(sKh + (16 * a + c) * P3T + ks * 32 + quad * 8);
          }
          const int nb = 64 * ch + 16 * a + 4 * quad;
#pragma unroll
          for (int g = 0; g < NG; g++) {
            f32x4 s = f32x4{0.f, 0.f, 0.f, 0.f};
#pragma unroll
            for (int ks = 0; ks < 2; ks++) {
              s = mfma16(kh_[ks], ql[g][ks], s);
            }
#pragma unroll
            for (int i = 0; i < 4; i++) pr[g][e][i] = (nb + i <= nmaxq[g]) ? __expf(s[i] * 0.125f - Mx[g]) * invL[g] : 0.f;
            float av = hsum8(pr[g][e][0] + pr[g][e][1] + pr[g][e][2] + 0.5f * pr[g][e][3]);
            float bv = hsum8(0.5f * pr[g][e][3]);
            const float bs = __shfl(bv, (lane + 48) & 63);
            av += (quad > 0) ? bs : carry[g];
            carry[g] = bs;
            if (h == 0) imp[(2 * g + qsel) * 260 + 16 * ch + 4 * a + quad] = av;
          }
        }
        bf16x8 vf[4];
#pragma unroll
        for (int dt = 0; dt < 4; dt++) {
          union { bf16x8 v; u32x2 u[2]; } t;
          t.u[0] = *(const u32x2*)(sV + (dt * 16 + c) * P3T + 32 * kk + 4 * quad);
          t.u[1] = *(const u32x2*)(sV + (dt * 16 + c) * P3T + 32 * kk + 16 + 4 * quad);
          vf[dt] = t.v;
        }
#pragma unroll
        for (int g = 0; g < NG; g++) {
          union { bf16x8 v; unsigned u[4]; } pf;
          pf.u[0] = pack2(pr[g][0][0], pr[g][0][1]);
          pf.u[1] = pack2(pr[g][0][2], pr[g][0][3]);
          pf.u[2] = pack2(pr[g][1][0], pr[g][1][1]);
          pf.u[3] = pack2(pr[g][1][2], pr[g][1][3]);
#pragma unroll
          for (int dt = 0; dt < 4; dt++) ocmp[g][dt] = __builtin_amdgcn_mfma_f32_16x16x32_bf16(vf[dt], pf.v, ocmp[g][dt], 0, 0, 0);
        }
      }
    }
#pragma unroll
    for (int g = 0; g < NG; g++) {
      const int tq = tw + 2 * g + qsel;
      const float g0 = gates[(size_t)tq * 48 + H * 3 + 0];
#pragma unroll
      for (int dt = 0; dt < 4; dt++) {
        u32x2 v;
        v.x = pack2(g0 * ocmp[g][dt][0], g0 * ocmp[g][dt][1]);
        v.y = pack2(g0 * ocmp[g][dt][2], g0 * ocmp[g][dt][3]);
        *(u32x2*)(part + (size_t)tq * 1024 + H * 64 + dt * 16 + 4 * quad) = v;
      }
    }
  }

#ifndef WINREP
#define WINREP 1
#endif
#pragma unroll 1
  for (int wrep = 0; wrep < WINREP; wrep++) {
    bf16x8 qh[NG][2];
    int tqs[NG];
#pragma unroll
    for (int g = 0; g < NG; g++) {
      tqs[g] = tw + 2 * g + qsel;
#pragma unroll
      for (int ks = 0; ks < 2; ks++) qh[g][ks] = *(const bf16x8*)(q_hi + (size_t)tqs[g] * 1024 + H * 64 + ks * 32 + quad * 8);
    }
    f32x4 ow[NG][4];
    float mw[NG], lw[NG];
#pragma unroll
    for (int g = 0; g < NG; g++) {
      mw[g] = NEGF; lw[g] = 0.f;
#pragma unroll
      for (int dt = 0; dt < 4; dt++) ow[g][dt] = f32x4{0.f, 0.f, 0.f, 0.f};
    }
    const u16* kwb = (const u16*)(ws + OFF_KW) + kvh * 64;
    const u16* vwt = (const u16*)(ws + OFF_VWT) + (size_t)(kvh * 64) * S_;
    int lo = t0 - 511; if (lo < 0) lo = 0;
    const int jlo = lo >> 6, jhi = (t0 + 8 * NG - 1) >> 6;
    u32x4 pk[2], pv[2];
#pragma unroll
    for (int i = 0; i < 2; i++) {
      pk[i] = *(const u32x4*)(kwb + (size_t)(64 * jlo + lr + 32 * i) * 128 + lcc);
      pv[i] = *(const u32x4*)(vwt + (size_t)(lr + 32 * i) * S_ + 64 * jlo + lcc);
    }
    for (int j = jlo; j <= jhi; j++) {
      __syncthreads();
#pragma unroll
      for (int i = 0; i < 2; i++) {
        *(u32x4*)(sKh + (lr + 32 * i) * P3T + lcc) = pk[i];
        *(u32x4*)(sV + (lr + 32 * i) * P3T + lcc) = pv[i];
      }
      __syncthreads();
      if (j + 1 <= jhi) {
#pragma unroll
        for (int i = 0; i < 2; i++) {
          pk[i] = *(const u32x4*)(kwb + (size_t)(64 * (j + 1) + lr + 32 * i) * 128 + lcc);
          pv[i] = *(const u32x4*)(vwt + (size_t)(lr + 32 * i) * S_ + 64 * (j + 1) + lcc);
        }
      }
      bf16x8 kf[4][2], vf[2][4];
#pragma unroll
      for (int a = 0; a < 4; a++)
#pragma unroll
        for (int ks = 0; ks < 2; ks++) kf[a][ks] = *(const bf16x8*)(sKh + (16 * a + c) * P3T + ks * 32 + quad * 8);
#pragma unroll
      for (int kk = 0; kk < 2; kk++)
#pragma unroll
        for (int dt = 0; dt < 4; dt++) {
          union { bf16x8 v; u32x2 u[2]; } t;
          t.u[0] = *(const u32x2*)(sV + (dt * 16 + c) * P3T + 32 * kk + 4 * quad);
          t.u[1] = *(const u32x2*)(sV + (dt * 16 + c) * P3T + 32 * kk + 16 + 4 * quad);
          vf[kk][dt] = t.v;
        }
#pragma unroll
      for (int g = 0; g < NG; g++) {
        f32x4 s[4];
#pragma unroll
        for (int a = 0; a < 4; a++) {
          s[a] = f32x4{0.f, 0.f, 0.f, 0.f};
#pragma unroll
          for (int ks = 0; ks < 2; ks++) s[a] = __builtin_amdgcn_mfma_f32_16x16x32_bf16(kf[a][ks], qh[g][ks], s[a], 0, 0, 0);
        }
        softmax_pv(s, 64 * j, true, tqs[g], 512, vf, ow[g], mw[g], lw[g], quad);
      }
    }
#pragma unroll
    for (int g = 0; g < NG; g++) {
      float L = lw[g] + __shfl_xor(lw[g], 16);
      L += __shfl_xor(L, 32);
      const float g2 = gates[(size_t)tqs[g] * 48 + H * 3 + 2] / fmaxf(L, 1e-30f);
#pragma unroll
      for (int dt = 0; dt < 4; dt++) {
        u16* pp = part + (size_t)tqs[g] * 1024 + H * 64 + dt * 16 + 4 * quad;
        u32x2 v = *(const u32x2*)pp;
        float y0 = __uint_as_float(v.x << 16) + g2 * ow[g][dt][0];
        float y1 = __uint_as_float(v.x & 0xffff0000u) + g2 * ow[g][dt][1];
        float y2 = __uint_as_float(v.y << 16) + g2 * ow[g][dt][2];
        float y3 = __uint_as_float(v.y & 0xffff0000u) + g2 * ow[g][dt][3];
        v.x = pack2(y0, y1); v.y = pack2(y2, y3);
        if (wrep == WINREP - 1 || L == 12345.678f) *(u32x2*)pp = v;
      }
    }
  }

#ifndef TOPKREP
#define TOPKREP 1
#endif
#pragma unroll 1
  for (int trep = 0; trep < TOPKREP; trep++) {
    const unsigned long long lt = (1ull << lane) - 1ull;
    unsigned bitsq[2 * NG][4], thq[2 * NG];
    int Rq[2 * NG];
    bool srch[2 * NG], act[2 * NG];
#pragma unroll
    for (int qi = 0; qi < 2 * NG; qi++) {
      const int cur = (tw + qi) >> 6;
#pragma unroll
      for (int e = 0; e < 4; e++) {
        const int jj = lane + 64 * e;
        const bool forced = (jj == 0) || (jj == cur) || (jj == cur - 1);
        const bool cand = (jj <= cur) && !forced;
        const float iv = imp[qi * 260 + jj];
        bitsq[qi][e] = cand ? __float_as_uint(iv) : 0u;
      }
      const int F = (cur == 0) ? 1 : ((cur == 1) ? 2 : 3);
      Rq[qi] = 16 - F;
      srch[qi] = (cur + 1 - F) > Rq[qi];
      act[qi] = srch[qi];
      thq[qi] = 0u;
    }
    for (int bit = 30; bit >= 0; bit--) {
      bool any = false;
#pragma unroll
      for (int qi = 0; qi < 2 * NG; qi++) {
        if (act[qi]) {
          const unsigned t2 = thq[qi] | (1u << bit);
          int cnt = 0;
#pragma unroll
          for (int e = 0; e < 4; e++) cnt += __popcll(__ballot(bitsq[qi][e] >= t2));
          if (cnt >= Rq[qi]) {
            thq[qi] = t2;
            if (cnt == Rq[qi]) act[qi] = false;
          }
        }
        any = any || act[qi];
      }
      if (!any) break;
    }
#pragma unroll
    for (int qi = 0; qi < 2 * NG; qi++) {
      const int cur = (tw + qi) >> 6;
      bool forced[4], cand[4], selv[4];
#pragma unroll
      for (int e = 0; e < 4; e++) {
        const int jj = lane + 64 * e;
        forced[e] = (jj == 0) || (jj == cur) || (jj == cur - 1);
        cand[e] = (jj <= cur) && !forced[e];
      }
      if (!srch[qi]) {
#pragma unroll
        for (int e = 0; e < 4; e++) selv[e] = forced[e] || cand[e];
      } else {
        const unsigned th = thq[qi];
        int cgt = 0;
#pragma unroll
        for (int e = 0; e < 4; e++) cgt += __popcll(__ballot(cand[e] && bitsq[qi][e] > th));
        const int need = Rq[qi] - cgt;
        int prior = 0;
#pragma unroll
        for (int e = 0; e < 4; e++) {
          const bool eq = cand[e] && bitsq[qi][e] == th;
          const unsigned long long m = __ballot(eq);
          const int rank = prior + __popcll(m & lt);
          selv[e] = forced[e] || (cand[e] && bitsq[qi][e] > th) || (eq && rank < need);
          prior += __popcll(m);
        }
      }
      if (qi & 1) {
#pragma unroll
        for (int e = 0; e < 4; e++) selv[e] = selv[e] && !forced[e];
      }
      int base = 0;
#pragma unroll
      for (int e = 0; e < 4; e++) {
        const unsigned long long m = __ballot(selv[e]);
        if (selv[e]) sel[qi * 16 + base + __popcll(m & lt)] = lane + 64 * e;
        base += __popcll(m);
      }
      if (lane == 0) seln[qi] = base;
    }
  }
  __builtin_amdgcn_wave_barrier();

  {
    const u16* ksb = (const u16*)(ws + OFF_KS) + (size_t)kvh * 256 * 4096 + lane * 8;
    const u16* vst = (const u16*)(ws + OFF_VST) + (size_t)kvh * 256 * 4096 + lane * 8;
    u16* ya = (u16*)(ws + OFF_QHI);
    const int curb = tw >> 6;
    bf16x8 qh[NG][2];
    f32x4 os[NG][4];
    float ms[NG], ls[NG];
    int tqs[NG], n0[NG], ntot[NG];
    u32x4 kn[NG][4][2], vn[NG][2][4];
    int jn[NG];
    int nmax = 0;
#pragma unroll
    for (int g = 0; g < NG; g++) {
      tqs[g] = tw + 2 * g + qsel;
      ms[g] = NEGF; ls[g] = 0.f;
#pragma unroll
      for (int ks = 0; ks < 2; ks++) qh[g][ks] = *(const bf16x8*)(q_hi + (size_t)tqs[g] * 1024 + H * 64 + ks * 32 + quad * 8);
#pragma unroll
      for (int dt = 0; dt < 4; dt++) os[g][dt] = f32x4{0.f, 0.f, 0.f, 0.f};
      n0[g] = __builtin_amdgcn_readfirstlane(seln[2 * g]);
      ntot[g] = n0[g] + __builtin_amdgcn_readfirstlane(seln[2 * g + 1]);
      nmax = ntot[g] > nmax ? ntot[g] : nmax;
      jn[g] = __builtin_amdgcn_readfirstlane(sel[(2 * g) * 16]);
      const u16* kp = ksb + (size_t)jn[g] * 4096;
      const u16* vp = vst + (size_t)jn[g] * 4096;
#pragma unroll
      for (int a = 0; a < 4; a++)
#pragma unroll
        for (int ks = 0; ks < 2; ks++) kn[g][a][ks] = *(const u32x4*)(kp + (a * 2 + ks) * 512);
#pragma unroll
      for (int kk = 0; kk < 2; kk++)
#pragma unroll
        for (int dt = 0; dt < 4; dt++) vn[g][kk][dt] = *(const u32x4*)(vp + (kk * 4 + dt) * 512);
    }
    for (int idx = 0; idx < nmax; idx++) {
#pragma unroll
      for (int g = 0; g < NG; g++) {
        const int jthis = jn[g];
        const bool valid = idx < ntot[g];
        const int qs = (idx < n0[g]) ? 0 : 1;
        f32x4 sc[4];
        bf16x8 vf[2][4];
#pragma unroll
        for (int a = 0; a < 4; a++) {
          sc[a] = f32x4{0.f, 0.f, 0.f, 0.f};
#pragma unroll
          for (int ks = 0; ks < 2; ks++) {
            union { bf16x8 v; u32x4 u; } t; t.u = kn[g][a][ks];
            sc[a] = __builtin_amdgcn_mfma_f32_16x16x32_bf16(t.v, qh[g][ks], sc[a], 0, 0, 0);
          }
        }
#pragma unroll
        for (int kk = 0; kk < 2; kk++)
#pragma unroll
          for (int dt = 0; dt < 4; dt++) { union { bf16x8 v; u32x4 u; } t; t.u = vn[g][kk][dt]; vf[kk][dt] = t.v; }
        const bool forced_blk = (jthis == 0) || (jthis == curb) || (jthis == curb - 1);
        softmax_pv(sc, 64 * jthis, valid && (forced_blk || (qsel == qs)), tqs[g], 1 << 30, vf, os[g], ms[g], ls[g], quad);
        int nx = idx + 1;
        nx = nx < ntot[g] ? nx : ntot[g] - 1;
        const int j = __builtin_amdgcn_readfirstlane((nx < n0[g]) ? sel[(2 * g) * 16 + nx] : sel[(2 * g + 1) * 16 + (nx - n0[g])]);
        jn[g] = j;
        const u16* kp = ksb + (size_t)j * 4096;
        const u16* vp = vst + (size_t)j * 4096;
#pragma unroll
        for (int a = 0; a < 4; a++)
#pragma unroll
          for (int ks = 0; ks < 2; ks++) kn[g][a][ks] = *(const u32x4*)(kp + (a * 2 + ks) * 512);
#pragma unroll
        for (int kk = 0; kk < 2; kk++)
#pragma unroll
          for (int dt = 0; dt < 4; dt++) vn[g][kk][dt] = *(const u32x4*)(vp + (kk * 4 + dt) * 512);
      }
    }
#pragma unroll
    for (int g = 0; g < NG; g++) {
      float L = ls[g] + __shfl_xor(ls[g], 16);
      L += __shfl_xor(L, 32);
      const float g1 = gates[(size_t)tqs[g] * 48 + H * 3 + 1] / fmaxf(L, 1e-30f);
#pragma unroll
      for (int dt = 0; dt < 4; dt++) {
        const u32x2 v = *(const u32x2*)(part + (size_t)tqs[g] * 1024 + H * 64 + dt * 16 + 4 * quad);
        float y0 = __uint_as_float(v.x << 16) + g1 * os[g][dt][0];
        float y1 = __uint_as_float(v.x & 0xffff0000u) + g1 * os[g][dt][1];
        float y2 = __uint_as_float(v.y << 16) + g1 * os[g][dt][2];
        float y3 = __uint_as_float(v.y & 0xffff0000u) + g1 * os[g][dt][3];
        u32x2 o;
        o.x = pack2(y0, y1); o.y = pack2(y2, y3);
        *(u32x2*)(ya + (size_t)tqs[g] * 1024 + H * 64 + dt * 16 + 4 * quad) = o;
      }
    }
  }
}

__device__ __forceinline__ void gr_tile(const Params& p, int t, char* smem) {
  char* ws = p.ws;
  const int tid = otid(), lane = tid & 63, wave = tid >> 6, quad = lane >> 4, r16 = lane & 15;
  const int m0 = (t >> 3) * 128, nti = t & 7;
  const u16* hh = (const u16*)(ws + OFF_HH);
  const u16* w1 = (const u16*)((char*)p.out + OO_W1T);
  u16* dst = (u16*)(ws + OFF_G);
  f32x4 acc[2][8];
  zero_acc(acc);
  gemm_acc(acc, hh + (size_t)m0 * 1024, 1024, w1 + (size_t)(3968 + nti * 128) * 1024, 1024, 1024, (u16*)smem, nullptr);
#pragma unroll
  for (int mt = 0; mt < 2; mt++)
#pragma unroll
    for (int nt = 0; nt < 8; nt++)
#pragma unroll
      for (int i = 0; i < 4; i++)
        dst[(size_t)(m0 + wave * 32 + mt * 16 + quad * 4 + i) * 1024 + nti * 128 + nt * 16 + r16] = f2bf(siluf_(acc[mt][nt][i]));
}

__device__ __forceinline__ void phase3(const Params& p, char* smem) {
  char* ws = p.ws;
  const int tid = otid(), lane = tid & 63, wave = tid >> 6, quad = lane >> 4, r16 = lane & 15;
  const int bid = obid();
  if (bid < 64) {
    u16* ut = (u16*)((char*)p.out + OO_UT);
    u16* rtb = ut;
    const int e0 = (bid * 256 + tid) * 8;
    const float dc = __expf(logg_of(e0 >> 15) * 128.f);
    float r[8];
#pragma unroll
    for (int k = 0; k < 8; k++) r[k] = 0.f;
#pragma unroll 8
    for (int cch = 0; cch < 128; cch++) {
      const u32x4 u = *(const u32x4*)(ut + (size_t)cch * 131072 + e0);
      u32x4 o;
      o.x = pack2(r[0], r[1]); o.y = pack2(r[2], r[3]); o.z = pack2(r[4], r[5]); o.w = pack2(r[6], r[7]);
      *(u32x4*)(rtb + (size_t)cch * 131072 + e0) = o;
      r[0] = r[0] * dc + __uint_as_float(u.x << 16); r[1] = r[1] * dc + __uint_as_float(u.x & 0xffff0000u);
      r[2] = r[2] * dc + __uint_as_float(u.y << 16); r[3] = r[3] * dc + __uint_as_float(u.y & 0xffff0000u);
      r[4] = r[4] * dc + __uint_as_float(u.z << 16); r[5] = r[5] * dc + __uint_as_float(u.z & 0xffff0000u);
      r[6] = r[6] * dc + __uint_as_float(u.w << 16); r[7] = r[7] * dc + __uint_as_float(u.w & 0xffff0000u);
    }
  }
  unsigned* ctr = (unsigned*)(ws + OFF_CTR);
  volatile unsigned* stask = (volatile unsigned*)(smem + P3_TASK);
  {
  for (int pass = 0; pass < 2; pass++) {
    const int kvh = (bid & 1) ^ pass;
    while (true) {
      __syncthreads();
      if (tid == 0) *stask = atomicAdd(ctr + kvh, 1u);
      __syncthreads();
      const unsigned t = *stask;
      if (t >= (unsigned)(S_ / (8 * NG))) break;
      attn_tile_task(p, S_ / (8 * NG) - 1 - (int)t, kvh, smem);
    }
  }
  }
}

__device__ __forceinline__ void phase4(const Params& p, char* smem) {
  char* ws = p.ws;
  u16* sA = (u16*)smem;
  u16* sB = sA + 128 * LDT;
  const u16* hh = (const u16*)(ws + OFF_HH);
  const u16* w1 = (const u16*)((char*)p.out + OO_W1T);
  const u16* qr = (const u16*)(ws + OFF_QR);
  const u16* kr = (const u16*)(ws + OFF_KR);
  const u16* vrt = (const u16*)(ws + OFF_VRT);
  const u16* rtb = (const u16*)((char*)p.out + OO_UT);
  u16* pbuf = (u16*)(ws + OFF_PBUF);
  u16* yr = (u16*)(ws + OFF_YR);
  for (int task = obid(); task < 512; task += gridDim.x) {
    const int cch = task >> 2, hd = task & 3, m0 = cch * 128;
    const int tid = otid(), lane = tid & 63, wave = tid >> 6, quad = lane >> 4, r16 = lane & 15;
    const float logg = logg_of(hd);
    const int rloc = wave * 32 + quad * 4;
    const u16* gbuf = (const u16*)(ws + OFF_G);
    u16* pb = pbuf + (size_t)task * 16384;
    {
      f32x4 acc[2][8];
      zero_acc(acc);
      gemm_acc(acc, qr + (size_t)m0 * 512 + hd * 128, 512, kr + (size_t)m0 * 512 + hd * 128, 512, 128, sA, sB);
      float cf[8];
#pragma unroll
      for (int nt = 0; nt < 8; nt++) cf[nt] = __expf(-logg * (float)(nt * 16 + r16));
#pragma unroll
      for (int mt = 0; mt < 2; mt++)
#pragma unroll
        for (int i = 0; i < 4; i++) {
          const int ii = rloc + mt * 16 + i;
          const float rf = __expf(logg * (float)ii);
#pragma unroll
          for (int nt = 0; nt < 8; nt++) {
            const int jj = nt * 16 + r16;
            float v = (ii >= jj) ? acc[mt][nt][i] * rf * cf[nt] : 0.f;
            pb[ii * 128 + jj] = f2bf(v);
          }
        }
    }
    asm volatile("s_waitcnt vmcnt(0)" ::: "memory");
    __syncthreads();
    float s1[2][4], s2[2][4];
#pragma unroll
    for (int mt = 0; mt < 2; mt++)
#pragma unroll
      for (int i = 0; i < 4; i++) { s1[mt][i] = 0.f; s2[mt][i] = 0.f; }
#pragma unroll 1
    for (int dvt = 0; dvt < 2; dvt++) {
      f32x4 ao[2][8];
      zero_acc(ao);
      gemm_acc(ao, qr + (size_t)m0 * 512 + hd * 128, 512, rtb + ((size_t)(cch * 4 + hd) * 256 + dvt * 128) * 128, 128, 128, sA, sB);
#pragma unroll
      for (int mt = 0; mt < 2; mt++)
#pragma unroll
        for (int i = 0; i < 4; i++) {
          float dq = __expf(logg * (float)(rloc + mt * 16 + i + 1));
#pragma unroll
          for (int nt = 0; nt < 8; nt++) ao[mt][nt][i] *= dq;
        }
      gemm_acc(ao, pb, 128, vrt + (size_t)(hd * 256 + dvt * 128) * S_ + m0, S_, 128, sA, sB);
#pragma unroll
      for (int mt = 0; mt < 2; mt++)
#pragma unroll
        for (int i = 0; i < 4; i++)
#pragma unroll
          for (int nt = 0; nt < 8; nt++) {
            const float v = ao[mt][nt][i];
            s1[mt][i] += v; s2[mt][i] += v * v;
            yr[(size_t)(m0 + rloc + mt * 16 + i) * 1024 + hd * 256 + dvt * 128 + nt * 16 + r16] = f2bf(v);
          }
    }
#pragma unroll
    for (int mt = 0; mt < 2; mt++)
#pragma unroll
      for (int i = 0; i < 4; i++) {
        float a = s1[mt][i], b = s2[mt][i];
        a += __shfl_xor(a, 1); a += __shfl_xor(a, 2); a += __shfl_xor(a, 4); a += __shfl_xor(a, 8);
        b += __shfl_xor(b, 1); b += __shfl_xor(b, 2); b += __shfl_xor(b, 4); b += __shfl_xor(b, 8);
        const float mean = a * (1.f / 256.f);
        const float var = fmaxf(b * (1.f / 256.f) - mean * mean, 0.f);
        const float rstd = rsqrtf(var + 1e-6f);
        const size_t row = (size_t)(m0 + rloc + mt * 16 + i);
#pragma unroll
        for (int dvt = 0; dvt < 2; dvt++)
#pragma unroll
          for (int nt = 0; nt < 8; nt++) {
            const int cg = hd * 256 + dvt * 128 + nt * 16 + r16;
            const float gs = bf2f(gbuf[row * 1024 + cg]);
            u16* q = yr + row * 1024 + hd * 256 + dvt * 128 + nt * 16 + r16;
            *q = f2bf(gs * (bf2f(*q) - mean) * rstd);
          }
      }
  }
}

__device__ __forceinline__ void phase5(const Params& p, char* smem) {
  char* ws = p.ws;
  u16* sA = (u16*)smem;
  u16* sB = sA + 128 * LDT;
  const int tid = otid(), lane = tid & 63, wave = tid >> 6, quad = lane >> 4, r16 = lane & 15;
  const u16* hh = (const u16*)(ws + OFF_HH);
  const u16* w1 = (const u16*)((char*)p.out + OO_W1T);
  const u16* ya = (const u16*)(ws + OFF_QHI);
  const u16* yr = (const u16*)(ws + OFF_YR);
  const u16* wba = (const u16*)(ws + OFF_WBA);
  const u16* wbb = (const u16*)(ws + OFF_WBB);
  float* mf = (float*)(ws + OFF_MERGEDF);
  u16* mg = (u16*)(ws + OFF_MERGED);
  for (int it = 0;; it++) {
    int mtile, nti; bool valid;
    if (!next_tile(it, 128, 8, 8, 8, mtile, nti, valid)) break;
    if (!valid) continue;
    const int m0 = mtile * 128, n0 = nti * 128;
    const int rbase = m0 + wave * 32 + quad * 4;
    f32x4 acc[2][8];
    zero_acc(acc);
    gemm_acc(acc, hh + (size_t)m0 * 1024, 1024, w1 + (size_t)(6016 + n0) * 1024, 1024, 1024, sA, sB);
#pragma unroll
    for (int mt = 0; mt < 2; mt++)
#pragma unroll
      for (int nt = 0; nt < 8; nt++)
#pragma unroll
        for (int i = 0; i < 4; i++) mf[(size_t)(rbase + mt * 16 + i) * 1024 + n0 + nt * 16 + r16] = sigmoidf_(acc[mt][nt][i]);
    zero_acc(acc);
    gemm_acc(acc, yr + (size_t)m0 * 1024, 1024, wbb + (size_t)n0 * 1024, 1024, 1024, sA, sB);
#pragma unroll
    for (int mt = 0; mt < 2; mt++)
#pragma unroll
      for (int nt = 0; nt < 8; nt++)
#pragma unroll
        for (int i = 0; i < 4; i++) {
          const size_t idx = (size_t)(rbase + mt * 16 + i) * 1024 + n0 + nt * 16 + r16;
          mf[idx] = mf[idx] * acc[mt][nt][i];
        }
    zero_acc(acc);
    gemm_acc(acc, hh + (size_t)m0 * 1024, 1024, w1 + (size_t)(4992 + n0) * 1024, 1024, 1024, sA, sB);
#pragma unroll
    for (int mt = 0; mt < 2; mt++)
#pragma unroll
      for (int nt = 0; nt < 8; nt++)
#pragma unroll
        for (int i = 0; i < 4; i++) mg[(size_t)(rbase + mt * 16 + i) * 1024 + n0 + nt * 16 + r16] = f2bf(sigmoidf_(acc[mt][nt][i]));
    zero_acc(acc);
    gemm_acc(acc, ya + (size_t)m0 * 1024, 1024, wba + (size_t)n0 * 1024, 1024, 1024, sA, sB);
#pragma unroll
    for (int mt = 0; mt < 2; mt++)
#pragma unroll
      for (int nt = 0; nt < 8; nt++)
#pragma unroll
        for (int i = 0; i < 4; i++) {
          const size_t idx = (size_t)(rbase + mt * 16 + i) * 1024 + n0 + nt * 16 + r16;
          mg[idx] = f2bf(bf2f(mg[idx]) * acc[mt][nt][i] + mf[idx]);
        }
  }
}

__device__ __forceinline__ void phase_proj(const Params& p, char* smem, const u16* A, int K, const u16* Wt, float* dst, float* ssq) {
  u16* sA = (u16*)smem;
  for (int it = 0;; it++) {
    int mtile, npair; bool valid;
    if (!next_tile(it, 128, 4, 16, 4, mtile, npair, valid)) break;
    if (!valid) continue;
    const int tid = otid(), lane = tid & 63, wave = tid >> 6, quad = lane >> 4, r16 = lane & 15;
    const int m0 = mtile * 128, n0 = npair * 256;
    const int rbase = m0 + wave * 32 + quad * 4;
    f32x4 acc[2][16];
#pragma unroll
    for (int mt = 0; mt < 2; mt++)
#pragma unroll
      for (int nt = 0; nt < 16; nt++) acc[mt][nt] = f32x4{0.f, 0.f, 0.f, 0.f};
    gemm_acc_wide(acc, A + (size_t)m0 * K, K, Wt + (size_t)n0 * K, K, K, sA);
#pragma unroll
    for (int mt = 0; mt < 2; mt++)
#pragma unroll
      for (int i = 0; i < 4; i++) {
        float sq = 0.f;
#pragma unroll
        for (int nt = 0; nt < 16; nt++) {
          float v = acc[mt][nt][i];
          dst[(size_t)(rbase + mt * 16 + i) * 1024 + n0 + nt * 16 + r16] = v;
          sq += v * v;
        }
        sq += __shfl_xor(sq, 1); sq += __shfl_xor(sq, 2); sq += __shfl_xor(sq, 4); sq += __shfl_xor(sq, 8);
        if (r16 == 0) { ssq[(size_t)(rbase + mt * 16 + i) * 8 + 2 * npair] = sq; ssq[(size_t)(rbase + mt * 16 + i) * 8 + 2 * npair + 1] = 0.f; }
      }
  }
}

__device__ __forceinline__ void phase7(const Params& p) {
  char* ws = p.ws;
  const int lane = otid() & 63, wave = otid() >> 6;
  const int gw = obid() * 4 + wave, nw = gridDim.x * 4;
  const float* mix = (const float*)(ws + OFF_MIX);
  const float* ssq = (const float*)(ws + OFF_SSQ1);
  u16* h2 = (u16*)(ws + OFF_H2);
  for (int row0 = gw * 4; row0 < S_; row0 += nw * 4) {
    f32x4 xv[4][4], mv[4][4], g[4];
    float rs[4], s2[4];
#pragma unroll
    for (int r = 0; r < 4; r++)
#pragma unroll
      for (int i = 0; i < 4; i++) {
        xv[r][i] = ((const f32x4*)(p.x + (size_t)(row0 + r) * 1024))[lane + 64 * i];
        mv[r][i] = ((const f32x4*)(mix + (size_t)(row0 + r) * 1024))[lane + 64 * i];
      }
#pragma unroll
    for (int i = 0; i < 4; i++) g[i] = ((const f32x4*)p.g_post_mix)[lane + 64 * i];
#pragma unroll
    for (int r = 0; r < 4; r++) {
      float ss = 0.f;
#pragma unroll
      for (int i = 0; i < 8; i++) ss += ssq[(size_t)(row0 + r) * 8 + i];
      rs[r] = rsqrtf(ss * (1.f / 1024.f) + 1e-6f);
    }
#pragma unroll
    for (int r = 0; r < 4; r++) {
      s2[r] = 0.f;
#pragma unroll
      for (int i = 0; i < 4; i++) {
        f32x4 v = xv[r][i] + mv[r][i] * g[i] * rs[r];
        xv[r][i] = v;
        s2[r] += v[0] * v[0] + v[1] * v[1] + v[2] * v[2] + v[3] * v[3];
        ((f32x4*)(p.out + (size_t)(row0 + r) * 1024))[lane + 64 * i] = v;
      }
    }
#pragma unroll
    for (int o = 32; o >= 1; o >>= 1)
#pragma unroll
      for (int r = 0; r < 4; r++) s2[r] += __shfl_xor(s2[r], o);
#pragma unroll
    for (int i = 0; i < 4; i++) g[i] = ((const f32x4*)p.g_pre_ffn)[lane + 64 * i];
#pragma unroll
    for (int r = 0; r < 4; r++) {
      const float rs2 = rsqrtf(s2[r] * (1.f / 1024.f) + 1e-6f);
#pragma unroll
      for (int i = 0; i < 4; i++) {
        const f32x4 v = xv[r][i] * g[i] * rs2;
        u32x2 H;
        H.x = pack2(v[0], v[1]); H.y = pack2(v[2], v[3]);
        *(u32x2*)(h2 + (size_t)(row0 + r) * 1024 + (lane + 64 * i) * 4) = H;
      }
    }
  }
}

__device__ __forceinline__ void phase8(const Params& p, char* smem) {
  char* ws = p.ws;
  u16* sA = (u16*)smem;
  u16* sB = sA + 128 * LDT;
  const int tid = otid(), lane = tid & 63, wave = tid >> 6, quad = lane >> 4, r16 = lane & 15;
  const u16* h2 = (const u16*)(ws + OFF_H2);
  const u16* wgu = (const u16*)(ws + OFF_WGU);
  u16* act = (u16*)(ws + OFF_ACT);
  for (int it = 0;; it++) {
    int mtile, nti; bool valid;
    if (!next_tile(it, 128, 44, 16, 4, mtile, nti, valid)) break;
    if (!valid) continue;
    const int m0 = mtile * 128;
    const int rbase = m0 + wave * 32 + quad * 4;
    f32x4 acc[2][8];
    zero_acc(acc);
    gemm_acc(acc, h2 + (size_t)m0 * 1024, 1024, wgu + (size_t)(nti * 128) * 1024, 1024, 1024, sA, sB);
#pragma unroll
    for (int mt = 0; mt < 2; mt++)
#pragma unroll
      for (int nt = 0; nt < 4; nt++)
#pragma unroll
        for (int i = 0; i < 4; i++)
          act[(size_t)(rbase + mt * 16 + i) * 2816 + nti * 64 + nt * 16 + r16] = f2bf(siluf_(acc[mt][nt][i]) * acc[mt][nt + 4][i]);
  }
}

__device__ __forceinline__ void phase10(const Params& p) {
  char* ws = p.ws;
  const int lane = otid() & 63, wave = otid() >> 6;
  const int gw = obid() * 4 + wave, nw = gridDim.x * 4;
  const float* f = (const float*)(ws + OFF_F);
  const float* ssq = (const float*)(ws + OFF_SSQ2);
  for (int row0 = gw * 4; row0 < S_; row0 += nw * 4) {
    f32x4 xv[4][4], fv[4][4], g[4];
    float rs[4];
#pragma unroll
    for (int r = 0; r < 4; r++)
#pragma unroll
      for (int i = 0; i < 4; i++) {
        xv[r][i] = ((const f32x4*)(p.out + (size_t)(row0 + r) * 1024))[lane + 64 * i];
        fv[r][i] = ((const f32x4*)(f + (size_t)(row0 + r) * 1024))[lane + 64 * i];
      }
#pragma unroll
    for (int i = 0; i < 4; i++) g[i] = ((const f32x4*)p.g_post_ffn)[lane + 64 * i];
#pragma unroll
    for (int r = 0; r < 4; r++) {
      float ss = 0.f;
#pragma unroll
      for (int i = 0; i < 8; i++) ss += ssq[(size_t)(row0 + r) * 8 + i];
      rs[r] = rsqrtf(ss * (1.f / 1024.f) + 1e-6f);
    }
#pragma unroll
    for (int r = 0; r < 4; r++)
#pragma unroll
      for (int i = 0; i < 4; i++) ((f32x4*)(p.out + (size_t)(row0 + r) * 1024))[lane + 64 * i] = xv[r][i] + fv[r][i] * g[i] * rs[r];
  }
}

__device__ __forceinline__ void run_phase(const Params& p, int ph, char* smem) {
  switch (ph) {
    case 0: phase0(p, smem); break;
    case 1: phase1(p, smem); break;
    case 2: phase2(p, smem); phase2_ut(p, smem); for (int t = obid(); t < 1024; t += gridDim.x) gr_tile(p, t, smem); break;
    case 3: phase3(p, smem); break;
    case 4: phase4(p, smem); break;
    case 5: phase5(p, smem); break;
    case 6: phase_proj(p, smem, (const u16*)(p.ws + OFF_MERGED), 1024, (const u16*)(p.ws + OFF_WOUT), (float*)(p.ws + OFF_MIX), (float*)(p.ws + OFF_SSQ1)); break;
    case 7: phase7(p); break;
    case 8: phase8(p, smem); break;
    case 9: phase_proj(p, smem, (const u16*)(p.ws + OFF_ACT), 2816, (const u16*)(p.ws + OFF_WD), (float*)(p.ws + OFF_F), (float*)(p.ws + OFF_SSQ2)); break;
    case 10: phase10(p); break;
  }
}

#define NPHASE 11

#if ONE_LAUNCH
#define XB_XCNT(j) (64 * (j))
#define XB_XSUB(j) (1024 + 64 * (j))
#define XB_XGEN(j) (2048 + 64 * (j))
#define XB_TOP 3072
#define XB_TOPGEN 3136
#define XB_WORDS 3200
__device__ __forceinline__ unsigned bar_ld(unsigned* p) { return __hip_atomic_load(p, __ATOMIC_RELAXED, __HIP_MEMORY_SCOPE_AGENT); }
__device__ __forceinline__ unsigned bar_add(unsigned* p) { return __hip_atomic_fetch_add(p, 1u, __ATOMIC_RELAXED, __HIP_MEMORY_SCOPE_AGENT); }
#define BAR_SPIN(cond) do { unsigned sp_ = 0; while (cond) { __builtin_amdgcn_s_sleep(1); if (++sp_ > (1u << 22)) break; } } while (0)
__device__ __forceinline__ unsigned xcc_id() { return (unsigned)__builtin_amdgcn_s_getreg((3 << 11) | 20) & 0xFu; }
__device__ __forceinline__ void fast_grid_barrier(unsigned* bar, unsigned x, volatile unsigned* st) {
  asm volatile("s_waitcnt vmcnt(0)" ::: "memory");
  __syncthreads();
  if (threadIdx.x == 0) {
    __builtin_amdgcn_s_waitcnt(0);
    unsigned nloc = st[0], nx = st[1];
    if (nloc == 0u) {
      const unsigned G = gridDim.x;
      unsigned sp = 0u;
      for (;;) {
        unsigned sum = 0u, cnt = 0u, mine = 0u;
#pragma unroll
        for (unsigned j = 0; j < 16; ++j) { const unsigned c = bar_ld(&bar[XB_XCNT(j)]); sum += c; cnt += (c > 0u) ? 1u : 0u; mine = (j == x) ? c : mine; }
        nloc = mine > 0u ? mine : 1u; nx = cnt > 0u ? cnt : 1u;
        if (sum == G) break;
        __builtin_amdgcn_s_sleep(1);
        if (++sp > (1u << 22)) break;
      }
      st[0] = nloc; st[1] = nx;
    }
    const unsigned old = bar_add(&bar[XB_XSUB(x)]);
    const unsigned gen = old / nloc;
    if (old + 1u == (gen + 1u) * nloc) {
      __builtin_amdgcn_fence(__ATOMIC_RELEASE, "agent");
      asm volatile("s_waitcnt vmcnt(0)" ::: "memory");
      const unsigned og = bar_add(&bar[XB_TOP]);
      const unsigned tg = og / nx;
      if (og + 1u == (tg + 1u) * nx) bar_add(&bar[XB_TOPGEN]);
      else BAR_SPIN(bar_ld(&bar[XB_TOPGEN]) == tg);
      __builtin_amdgcn_fence(__ATOMIC_ACQUIRE, "agent");
      bar_add(&bar[XB_XGEN(x)]);
      asm volatile("s_waitcnt vmcnt(0)" ::: "memory");
    } else {
      BAR_SPIN(bar_ld(&bar[XB_XGEN(x)]) == gen);
      __builtin_amdgcn_fence(__ATOMIC_ACQUIRE, "agent");
      asm volatile("s_waitcnt vmcnt(0)" ::: "memory");
    }
  }
  __syncthreads();
}

__global__ void __launch_bounds__(256, 2) mega_kernel(Params p) {
  extern __shared__ __attribute__((aligned(16))) char smem[];
  cg::grid_group grid = cg::this_grid();
#ifndef REPMASK
#define REPMASK 0
#endif
  if (threadIdx.x == 0) {
    volatile unsigned* bst = (volatile unsigned*)(smem + 73728);
    bst[0] = 0u; bst[1] = 0u;
    bar_add((unsigned*)(p.ws + OFF_BAR) + XB_XCNT(xcc_id()));
  }
  __syncthreads();
  for (int ph = 0; ph < NPHASE; ph++) {
    run_phase(p, ph, smem);
    if ((REPMASK >> ph) & 1) { grid.sync(); run_phase(p, ph, smem); }
    if (ph + 1 < NPHASE) fast_grid_barrier((unsigned*)(p.ws + OFF_BAR), xcc_id(), (volatile unsigned*)(smem + 73728));
    if (p.ws == nullptr) grid.sync();
  }
}

#else
template <int PH>
__global__ void __launch_bounds__(256, 2) phase_kernel(Params p) {
  extern __shared__ __attribute__((aligned(16))) char smem[];
  run_phase(p, PH, smem);
}

#endif

extern "C" void kernel_launch(void* const* d_in, const int* in_sizes, int n_in, void* d_out, int out_size, void* d_ws, size_t ws_size,
                              hipStream_t stream) {
  Params p{};
  p.x = (const float*)d_in[0]; p.g_pre_mix = (const float*)d_in[1]; p.w_in = (const float*)d_in[2];
  p.cpk = (const float*)d_in[3]; p.cw1k = (const float*)d_in[4]; p.cw2k = (const float*)d_in[5];
  p.cpv = (const float*)d_in[6]; p.cw1v = (const float*)d_in[7]; p.cw2v = (const float*)d_in[8];
  p.wba = (const float*)d_in[9]; p.wbb = (const float*)d_in[10]; p.wout = (const float*)d_in[11];
  p.g_post_mix = (const float*)d_in[12]; p.g_pre_ffn = (const float*)d_in[13];
  p.wg = (const float*)d_in[14]; p.wu = (const float*)d_in[15]; p.wd = (const float*)d_in[16]; p.g_post_ffn = (const float*)d_in[17];
  p.out = (float*)d_out; p.ws = (char*)d_ws;
#if ONE_LAUNCH
  static int grid_blocks = 0;
  if (!grid_blocks) {
    int dev = 0, cus = 0, per_cu = 0;
    hipGetDevice(&dev);
    hipDeviceGetAttribute(&cus, hipDeviceAttributeMultiprocessorCount, dev);
    hipFuncSetAttribute((const void*)mega_kernel, hipFuncAttributeMaxDynamicSharedMemorySize, SMEM_BYTES);
    hipOccupancyMaxActiveBlocksPerMultiprocessor(&per_cu, mega_kernel, 256, SMEM_BYTES);
    if (per_cu > 2) per_cu = 2;
    if (per_cu < 1) per_cu = 1;
    grid_blocks = cus * per_cu;
  }
  hipMemsetAsync((char*)d_ws + OFF_CTR, 0, 4096 + 4 * XB_WORDS, stream);
  void* args[] = {&p};
  hipError_t e = hipLaunchCooperativeKernel((void*)mega_kernel, dim3(grid_blocks), dim3(256), args, SMEM_BYTES, stream);
  if (e != hipSuccess) fprintf(stderr, "cooperative launch failed: %s (grid %d)\n", hipGetErrorString(e), grid_blocks);
#else
  hipLaunchKernelGGL(phase_kernel<0>, dim3(512), dim3(256), SMEM_BYTES, stream, p);
  hipLaunchKernelGGL(phase_kernel<1>, dim3(512), dim3(256), SMEM_BYTES, stream, p);
  hipLaunchKernelGGL(phase_kernel<2>, dim3(512), dim3(256), SMEM_BYTES, stream, p);
  hipLaunchKernelGGL(phase_kernel<3>, dim3(512), dim3(256), SMEM_BYTES, stream, p);
  hipLaunchKernelGGL(phase_kernel<4>, dim3(512), dim3(256), SMEM_BYTES, stream, p);
  hipLaunchKernelGGL(phase_kernel<5>, dim3(512), dim3(256), SMEM_BYTES, stream, p);
  hipLaunchKernelGGL(phase_kernel<6>, dim3(512), dim3(256), SMEM_BYTES, stream, p);
  hipLaunchKernelGGL(phase_kernel<7>, dim3(512), dim3(256), SMEM_BYTES, stream, p);
  hipLaunchKernelGGL(phase_kernel<8>, dim3(512), dim3(256), SMEM_BYTES, stream, p);
  hipLaunchKernelGGL(phase_kernel<9>, dim3(512), dim3(256), SMEM_BYTES, stream, p);
  hipLaunchKernelGGL(phase_kernel<10>, dim3(512), dim3(256), SMEM_BYTES, stream, p);
#endif
}
```
